# Optimizing an MI355X kernel written in HIP

```python
import jax, jax.numpy as jnp
from jax import lax
import numpy as np

D_MODEL = 1024
BATCH = 32
SEQ = 2048
DEPTH = 4

GRID_W = 64
CTX_LEN = 256
N_MIXERS = 3
NORM_EPS = 1e-6

A_WIDTH = 2 * D_MODEL
A_CHUNK = 128
A_GROUPS = 8
B_WIDTH = 2 * D_MODEL
B_WINDOWS = (2, 4, 8, 16)
B_GROUP_W = B_WIDTH // len(B_WINDOWS)
C_HEAD_DIM = 64
C_Q_HEADS = D_MODEL // C_HEAD_DIM
C_KV_HEADS = C_Q_HEADS // 4
C_GROUP = C_Q_HEADS // C_KV_HEADS
C_QW = C_Q_HEADS * C_HEAD_DIM
C_KVW = C_KV_HEADS * C_HEAD_DIM
C_WINDOW = 128
C_BLOCK = 128
ROPE_THETA = 10000.0

kernel_name = 'hybrid_gmlp_pool_swa_prefix_dit'


def _rmsnorm(x, g):
    xf = x.astype(jnp.float32)
    y = xf * lax.rsqrt(jnp.mean(xf * xf, axis=-1, keepdims=True) + NORM_EPS)
    return (y * g.astype(jnp.float32)).astype(x.dtype)


def _layernorm(x, g, b):
    xf = x.astype(jnp.float32)
    mu = jnp.mean(xf, axis=-1, keepdims=True)
    var = jnp.mean(jnp.square(xf - mu), axis=-1, keepdims=True)
    y = (xf - mu) * lax.rsqrt(var + NORM_EPS) * g.astype(jnp.float32) + b.astype(jnp.float32)
    return y.astype(x.dtype)


def _chunk_gmlp(h, w_in, vn_g, vn_b, w_s, b_s, w_out):
    bn, L, _ = h.shape
    u, v, gate = jnp.split(h @ w_in, 3, axis=-1)
    u = jax.nn.gelu(u)
    v = _layernorm(jax.nn.gelu(v), vn_g, vn_b)
    vc = v.reshape(bn, L // A_CHUNK, A_CHUNK, A_GROUPS, A_WIDTH // A_GROUPS)
    s = jnp.einsum('gpq,bnqgc->bnpgc', w_s, vc) + b_s.T[None, None, :, :, None]
    y = u * s.reshape(bn, L, A_WIDTH)
    return (y * jax.nn.silu(gate)) @ w_out


def _centred_mean(p, w):
    bn, L, ch = p.shape
    cs = jnp.concatenate([jnp.zeros((bn, 1, ch), jnp.float32),
                          jnp.cumsum(p.astype(jnp.float32), axis=1)], axis=1)
    t = jnp.arange(L)
    lo = jnp.clip(t - w // 2, 0, L)
    hi = jnp.clip(t + w // 2, 0, L)
    cnt = (hi - lo).astype(jnp.float32)
    return ((cs[:, hi] - cs[:, lo]) / cnt[None, :, None]).astype(p.dtype)


def _multiscale_pool(h, w_in, w_grp, scale, w_out):
    p, gate = jnp.split(h @ w_in, 2, axis=-1)
    groups = jnp.split(p, len(B_WINDOWS), axis=-1)
    pooled = jnp.stack([_centred_mean(g, w) - g for g, w in zip(groups, B_WINDOWS)], axis=2)
    mixed = jnp.einsum('blgc,gcd->blgd', pooled, w_grp).reshape(h.shape[0], h.shape[1], B_WIDTH) * scale
    return (mixed * jax.nn.silu(gate)) @ w_out


def _axial_rope_tables(rows):
    row = jnp.repeat(jnp.arange(rows), GRID_W).astype(jnp.float32)
    col = jnp.tile(jnp.arange(GRID_W), rows).astype(jnp.float32)
    n_freq = C_HEAD_DIM // 4
    inv = ROPE_THETA ** (-jnp.arange(n_freq, dtype=jnp.float32) / n_freq)
    ang = jnp.concatenate([row[:, None] * inv, col[:, None] * inv], axis=-1)
    return jnp.cos(ang), jnp.sin(ang)


def _apply_rope(x, cos, sin):
    shp = (1, cos.shape[0]) + (1,) * (x.ndim - 3) + (cos.shape[1],)
    c = cos.reshape(shp)
    s = sin.reshape(shp)
    x1, x2 = jnp.split(x.astype(jnp.float32), 2, axis=-1)
    return jnp.concatenate([x1 * c - x2 * s, x2 * c + x1 * s], axis=-1).astype(x.dtype)


def _heads_q(t):
    return t.reshape(t.shape[:2] + (C_KV_HEADS, C_GROUP, C_HEAD_DIM))


def _heads_kv(t):
    return t.reshape(t.shape[:2] + (C_KV_HEADS, C_HEAD_DIM))


def _banded_attention(q, k, v, kc, vc, sink):
    bn, S = q.shape[:2]
    lc = kc.shape[1]
    nb = S // C_BLOCK
    span = C_BLOCK + 2 * C_WINDOW
    pad = ((0, 0), (C_WINDOW, C_WINDOW), (0, 0), (0, 0))
    kp = jnp.pad(k, pad)
    vp = jnp.pad(v, pad)
    scale = C_HEAD_DIM ** -0.5
    rel = jnp.arange(C_BLOCK)[:, None] + C_WINDOW - jnp.arange(span)[None, :]
    band = jnp.abs(rel) <= C_WINDOW
    sink_b = sink.astype(jnp.float32).reshape(C_KV_HEADS, C_GROUP)[None, :, :, None, None]
    neg = jnp.finfo(jnp.float32).min

    def one_block(n):
        start = n * C_BLOCK
        qb = lax.dynamic_slice_in_dim(q, start, C_BLOCK, axis=1)
        kb = lax.dynamic_slice_in_dim(kp, start, span, axis=1)
        vb = lax.dynamic_slice_in_dim(vp, start, span, axis=1)
        kpos = start - C_WINDOW + jnp.arange(span)
        valid = band & ((kpos >= 0) & (kpos < S))[None, :]
        s_loc = jnp.einsum('bqkgd,bskd->bkgqs', qb, kb).astype(jnp.float32) * scale
        s_loc = jnp.where(valid, s_loc, neg)
        s_ctx = jnp.einsum('bqkgd,bskd->bkgqs', qb, kc).astype(jnp.float32) * scale
        s_snk = jnp.broadcast_to(sink_b, s_loc.shape[:-1] + (1,))
        p = jax.nn.softmax(jnp.concatenate([s_loc, s_ctx, s_snk], axis=-1), axis=-1)
        p_loc = p[..., :span].astype(v.dtype)
        p_ctx = p[..., span:span + lc].astype(v.dtype)
        return (jnp.einsum('bkgqs,bskd->bqkgd', p_loc, vb)
                + jnp.einsum('bkgqs,bskd->bqkgd', p_ctx, vc))

    outs = lax.map(one_block, jnp.arange(nb))
    return jnp.moveaxis(outs, 0, 1).reshape(bn, S, C_QW)


def _context_attention(qc, kc, vc, sink):
    scale = C_HEAD_DIM ** -0.5
    s = jnp.einsum('bqkgd,bskd->bkgqs', qc, kc).astype(jnp.float32) * scale
    sink_b = sink.astype(jnp.float32).reshape(C_KV_HEADS, C_GROUP)[None, :, :, None, None]
    s = jnp.concatenate([s, jnp.broadcast_to(sink_b, s.shape[:-1] + (1,))], axis=-1)
    p = jax.nn.softmax(s, axis=-1)[..., :-1].astype(vc.dtype)
    o = jnp.einsum('bkgqs,bskd->bqkgd', p, vc)
    return o.reshape(qc.shape[0], qc.shape[1], C_QW)


def _n_of_kind(kind):
    return len(range(kind, DEPTH, N_MIXERS))


def setup_inputs(seed: int = 0) -> dict:
    key = jax.random.key(seed)
    ks = iter(jax.random.split(key, 32))
    nrm = lambda shape, s: jax.random.normal(next(ks), shape, jnp.float32) * s
    nA, nB, nC = _n_of_kind(0), _n_of_kind(1), _n_of_kind(2)
    D = D_MODEL
    return {
        'x': nrm((BATCH, SEQ, D), 1.0),
        'c': nrm((BATCH, D), 1.0),
        'ctx': nrm((BATCH, CTX_LEN, D), 1.0),
        'c_ctx': nrm((D,), 1.0),
        'ada_w': nrm((DEPTH, D, 3 * D), 0.5 * D ** -0.5),
        'ada_b': nrm((DEPTH, 3 * D), 0.02),
        'norm_g': 1.0 + nrm((DEPTH, D), 0.02),
        'final_g': 1.0 + nrm((D,), 0.02),
        'gmlp_w_in': nrm((nA, D, 3 * A_WIDTH), D ** -0.5),
        'gmlp_vnorm_g': 1.0 + nrm((nA, A_WIDTH), 0.02),
        'gmlp_vnorm_b': nrm((nA, A_WIDTH), 0.02),
        'gmlp_w_s': nrm((nA, A_GROUPS, A_CHUNK, A_CHUNK), A_CHUNK ** -0.5),
        'gmlp_b_s': 1.0 + nrm((nA, A_GROUPS, A_CHUNK), 0.02),
        'gmlp_w_out': nrm((nA, A_WIDTH, D), A_WIDTH ** -0.5),
        'pool_w_in': nrm((nB, D, 2 * B_WIDTH), D ** -0.5),
        'pool_w_grp': nrm((nB, len(B_WINDOWS), B_GROUP_W, B_GROUP_W), B_GROUP_W ** -0.5),
        'pool_scale': 1.0 + nrm((nB, B_WIDTH), 0.1),
        'pool_w_out': nrm((nB, B_WIDTH, D), B_WIDTH ** -0.5),
        'attn_w_in': nrm((nC, D, 2 * C_QW + 2 * C_KVW), D ** -0.5),
        'attn_sink': nrm((nC, C_Q_HEADS), 1.0),
        'attn_w_out': nrm((nC, C_QW, D), C_QW ** -0.5),
    }


def reference(x, c, ctx, c_ctx, ada_w, ada_b, norm_g, final_g,
              gmlp_w_in, gmlp_vnorm_g, gmlp_vnorm_b, gmlp_w_s, gmlp_b_s, gmlp_w_out,
              pool_w_in, pool_w_grp, pool_scale, pool_w_out,
              attn_w_in, attn_sink, attn_w_out):
    ROWS = x.shape[1] // GRID_W
    cos, sin = _axial_rope_tables(ROWS)
    cond_lat = jax.nn.silu(c.astype(jnp.float32))
    cond_ctx = jax.nn.silu(c_ctx.astype(jnp.float32))
    for i in range(DEPTH):
        kind = i % N_MIXERS
        j = i // N_MIXERS
        ctx_out = any(l % N_MIXERS == 2 for l in range(i + 1, DEPTH))
        ctx_in = ctx_out or kind == 2

        shift, scale, gate = jnp.split((cond_lat @ ada_w[i] + ada_b[i]).astype(x.dtype), 3, axis=-1)
        h = _rmsnorm(x, norm_g[i]) * (1 + scale[:, None]) + shift[:, None]
        if ctx_in:
            shift_c, scale_c, gate_c = jnp.split((cond_ctx @ ada_w[i] + ada_b[i]).astype(ctx.dtype), 3, axis=-1)
            hc = _rmsnorm(ctx, norm_g[i]) * (1 + scale_c) + shift_c

        if kind == 0:
            args = (gmlp_w_in[j], gmlp_vnorm_g[j], gmlp_vnorm_b[j], gmlp_w_s[j], gmlp_b_s[j], gmlp_w_out[j])
            y = _chunk_gmlp(h, *args)
            if ctx_out:
                yc = _chunk_gmlp(hc, *args)
        elif kind == 1:
            args = (pool_w_in[j], pool_w_grp[j], pool_scale[j], pool_w_out[j])
            y = _multiscale_pool(h, *args)
            if ctx_out:
                yc = _multiscale_pool(hc, *args)
        else:
            w_in = attn_w_in[j]
            q, k, v, g_att = jnp.split(h @ w_in, [C_QW, C_QW + C_KVW, C_QW + 2 * C_KVW], axis=-1)
            q = _apply_rope(_heads_q(q), cos, sin)
            k = _apply_rope(_heads_kv(k), cos, sin)
            v = _heads_kv(v)
            kc, vc = jnp.split(hc @ w_in[:, C_QW:C_QW + 2 * C_KVW], 2, axis=-1)
            kc = _heads_kv(kc)
            vc = _heads_kv(vc)
            o = _banded_attention(q, k, v, kc, vc, attn_sink[j])
            y = (o * jax.nn.silu(g_att)) @ attn_w_out[j]
            if ctx_out:
                qc = _heads_q(hc @ w_in[:, :C_QW])
                gc = hc @ w_in[:, C_QW + 2 * C_KVW:]
                yc = (_context_attention(qc, kc, vc, attn_sink[j]) * jax.nn.silu(gc)) @ attn_w_out[j]

        x = x + gate[:, None] * y
        if ctx_out:
            ctx = ctx + gate_c * yc
    return _rmsnorm(x, final_g)
```

```cpp
#include <hip/hip_runtime.h>
#include <hip/hip_cooperative_groups.h>
#include <cstdio>
namespace cg = cooperative_groups;

#define LAS __attribute__((address_space(3)))
typedef unsigned short bf16_t;
typedef short bf16x8 __attribute__((ext_vector_type(8)));
typedef short s16x4 __attribute__((ext_vector_type(4)));
typedef float f32x2 __attribute__((ext_vector_type(2)));
typedef float f32x4 __attribute__((ext_vector_type(4)));
typedef float f32x16 __attribute__((ext_vector_type(16)));
typedef unsigned u32x2 __attribute__((ext_vector_type(2)));
typedef unsigned u32x4 __attribute__((ext_vector_type(4)));

constexpr int DM = 1024, NB = 32, SEQ = 2048, LC = 256;
constexpr int ML = NB * SEQ, MC = NB * LC, MT = ML + MC;
constexpr int MODSZ = 33 * 3072;
constexpr float L2E = 1.4426950408889634f;

constexpr size_t MiB = 1u << 20;
constexpr size_t WS_MOD = 0;
constexpr size_t WS_ROPEC = 2 * MiB;
constexpr size_t WS_ROPES = 2 * MiB + 512 * 1024;
constexpr size_t WS_CTL = 3 * MiB;
constexpr size_t WS_GIN0 = 4 * MiB;
constexpr size_t WS_GIN1 = 16 * MiB;
constexpr size_t WS_GOUT0 = 28 * MiB;
constexpr size_t WS_GOUT1 = 32 * MiB;
constexpr size_t WS_GWS = 36 * MiB;
constexpr size_t WS_PINNT = 37 * MiB;
constexpr size_t WS_PINT = 41 * MiB;
constexpr size_t WS_PGRPT = 49 * MiB;
constexpr size_t WS_POUT = 51 * MiB;
constexpr size_t WS_AIN = 55 * MiB;
constexpr size_t WS_AOUT = 60 * MiB;
constexpr size_t WS_XC = 64 * MiB;
constexpr size_t WS_STATS = 96 * MiB;
constexpr size_t WS_R0 = 116 * MiB;
constexpr size_t WS_R1 = 404 * MiB;
constexpr size_t WS_R2 = 692 * MiB;
constexpr size_t WS_BIAS = 980 * MiB;
constexpr size_t WS_SHIFT16 = 984 * MiB;
constexpr size_t WS_SUMSQ = 3 * MiB + 65536;
constexpr size_t WS_END = 986 * MiB;

constexpr int LDS_BYTES = 147456;

typedef __bf16 bf16x2_t __attribute__((ext_vector_type(2)));
__device__ __forceinline__ unsigned cvt_pk_bf16(float lo, float hi) { const f32x2 v = {lo, hi}; const bf16x2_t r = __builtin_convertvector(v, bf16x2_t); return __builtin_bit_cast(unsigned, r); }
__device__ __forceinline__ float bf_lo(unsigned w) { return __uint_as_float(w << 16); }
__device__ __forceinline__ float bf_hi(unsigned w) { return __uint_as_float(w & 0xffff0000u); }
__device__ __forceinline__ float fexp2(float x) { return __builtin_amdgcn_exp2f(x); }
__device__ __forceinline__ float frcp(float x) { return __builtin_amdgcn_rcpf(x); }
__device__ __forceinline__ float silu_f(float x) { return x * frcp(1.0f + fexp2(-L2E * x)); }
__device__ __forceinline__ float gelu_f(float x) { const float t = x * (1.0f + 0.044715f * x * x); return x * frcp(1.0f + fexp2(-2.302208198f * t)); }
__device__ __forceinline__ f32x2 ugate2(f32x2 u, f32x2 g) {
    const f32x2 a = u * (u * u * (-0.1029432397f) + (-2.302208198f));
    const f32x2 b = g * (-L2E);
    const f32x2 e1 = (f32x2){fexp2(a[0]), fexp2(a[1])}, e2 = (f32x2){fexp2(b[0]), fexp2(b[1])};
    const f32x2 d1 = e1 + 1.0f, d = d1 + e2 * d1;
    return (u * g) * (f32x2){frcp(d[0]), frcp(d[1])};
}
__device__ __forceinline__ f32x2 gelu2(f32x2 u) {
    const f32x2 a = u * (u * u * (-0.1029432397f) + (-2.302208198f));
    const f32x2 d = (f32x2){fexp2(a[0]), fexp2(a[1])} + 1.0f;
    return u * (f32x2){frcp(d[0]), frcp(d[1])};
}
__device__ __forceinline__ int get_tid(int wv) { int t = wv * 64 + (int)__builtin_amdgcn_mbcnt_hi(~0u, __builtin_amdgcn_mbcnt_lo(~0u, 0u)); asm volatile("" : "+v"(t)); return t; }
__device__ __forceinline__ int unit_remap(int L, int n, bool rev) { if (rev) L = n - 1 - L; return (L & 7) * (n >> 3) + (L >> 3); }
__device__ __forceinline__ float shx(float v, int mask, int lane) { return __int_as_float(__builtin_amdgcn_ds_bpermute((lane ^ mask) << 2, __float_as_int(v))); }
__device__ __forceinline__ float wave_sum(float v, int lane) {
#pragma unroll
    for (int o = 1; o < 64; o <<= 1) v += shx(v, o, lane);
    return v;
}

namespace pg8 {
constexpr int BM = 256, BK = 64, HALF = 128, HTB = HALF * BK * 2, STAGE_BYTES = 8 * HTB, NXCD = 8, WGM = 8;
__device__ __forceinline__ int lds_byte(int r, int c) { const int st = (r >> 4) * 2 + (c >> 5), rr = r & 15, cc = c & 31, ob = rr * 64 + cc * 2; return st * 1024 + (ob ^ (((ob >> 9) & 1) << 5)); }
__device__ __forceinline__ void stage_rc(int b, int& R, int& C) { const int st = b / 1024, sb = b % 1024, swz = sb ^ (((sb >> 9) & 1) << 5); R = (st >> 1) * 16 + swz / 64; C = (st & 1) * 32 + (swz % 64) / 2; }
__device__ __forceinline__ int perm32(int rho) { const int n = rho >> 4, i = rho & 15; return 8 * (i >> 2) + 4 * n + (i & 3); }
struct Unit { int pm, pn; };
struct Gemm { const bf16_t* A; const bf16_t* Bt; int M, N, K, lda, ldb; int bsh; unsigned bmul; };
struct StaticOrder {
    int nM, nN, nwg, G, c, rev;
    __device__ void init(int M, int N, int G_, int c_, int rev_) { nM = M / BM; nN = N / BM; nwg = nM * nN; G = G_; c = c_; rev = rev_; }
    __device__ bool next(int i, Unit& u) const {
        const long L = (long)i * G + c; if (L >= nwg) return false;
        int wgid = rev ? (nwg - 1 - (int)L) : (int)L; { const int q = nwg / NXCD, r = nwg % NXCD, xcd = wgid % NXCD, off = wgid / NXCD; wgid = (xcd < r ? xcd * (q + 1) : r * (q + 1) + (xcd - r) * q) + off; }
        const int nig = WGM * nN, gid = wgid / nig, fm = gid * WGM, gsz = (nM - fm) < WGM ? (nM - fm) : WGM;
        u.pm = fm + ((wgid % nig) % gsz); u.pn = (wgid % nig) / gsz; return true;
    }
};

template <class Epi>
__device__ __forceinline__ void gemm_phase(int wv, LAS unsigned char* lds, const Gemm g, const StaticOrder& S, const Epi& E) {
    const int tid = get_tid(wv), wid = __builtin_amdgcn_readfirstlane(tid >> 6), lane = tid & 63, wr = wid >> 2, wc = wid & 3, fr = lane & 15, fq = lane >> 4;
    const int K = g.K, nt = K / BK;
    unsigned voffA[2], voffB[2];
#pragma unroll
    for (int i = 0; i < 2; ++i) { int R, C; stage_rc(tid * 16 + i * 8192, R, C); const int Rb = (R & ~31) + perm32(R & 31);
        voffA[i] = (unsigned)(R * g.lda + C) * 2u; voffB[i] = (unsigned)(Rb * g.ldb + C) * 2u; }
    const size_t kstep = (size_t)(BK * 2);
    const size_t hstepA = (size_t)HALF * g.lda * 2, hstepB = (size_t)HALF * g.ldb * 2;
    const size_t tstepA = 2 * hstepA, tstepB = 2 * hstepB;
    const unsigned ldsw = (unsigned)wid * 1024u;
    const int aoff = lds_byte(wr * 64 + fr, fq * 8), boff = lds_byte(wc * 32 + fr, fq * 8);
#define PG8_SA(b, h) (((b) * 2 + (h)) * HTB)
#define PG8_SB(b, h) ((4 + (b) * 2 + (h)) * HTB)
#define PG8_STAGE(bufoff, gbase, voff) do { _Pragma("unroll") for (int _i = 0; _i < 2; ++_i) \
        __builtin_amdgcn_global_load_lds((const unsigned*)((const char*)(gbase) + (voff)[_i]), (LAS unsigned*)(lds + (bufoff) + ldsw + _i * 8192), 16, 0, 0); } while (0)
#define PG8_LDA(dst, b, h) do { _Pragma("unroll") for (int m = 0; m < 4; ++m) _Pragma("unroll") for (int k = 0; k < 2; ++k) dst[m][k] = *(const LAS bf16x8*)(lds + PG8_SA(b, h) + aoff + m * 2048 + k * 1024); } while (0)
#define PG8_LDB(dst, b, h) do { _Pragma("unroll") for (int n = 0; n < 2; ++n) _Pragma("unroll") for (int k = 0; k < 2; ++k) dst[n][k] = *(const LAS bf16x8*)(lds + PG8_SB(b, h) + boff + n * 2048 + k * 1024); } while (0)
#define PG8_MMA(ai, bj, At, Bt) do { __builtin_amdgcn_s_setprio(1); _Pragma("unroll") for (int m = 0; m < 4; ++m) _Pragma("unroll") for (int n = 0; n < 2; ++n) _Pragma("unroll") for (int k = 0; k < 2; ++k) \
        acc[ai][bj][m][n] = __builtin_amdgcn_mfma_f32_16x16x32_bf16(Bt[n][k], At[m][k], acc[ai][bj][m][n], 0, 0, 0); __builtin_amdgcn_s_setprio(0); } while (0)
#define PG8_WAIT_V(n) asm volatile("s_waitcnt vmcnt(" #n ")" ::: "memory")
#define PG8_WAIT_L(n) asm volatile("s_waitcnt lgkmcnt(" #n ")" ::: "memory")
#define PG8_BAR __builtin_amdgcn_s_barrier()
#define PG8_SCHED __builtin_amdgcn_sched_barrier(0)
    Unit cur, nxt; int ui = 0;
    if (!S.next(0, cur)) return;
    f32x4 acc[2][2][4][2];
#pragma unroll
    for (int a = 0; a < 2; ++a)
#pragma unroll
        for (int b = 0; b < 2; ++b)
#pragma unroll
            for (int m = 0; m < 4; ++m)
#pragma unroll
                for (int n = 0; n < 2; ++n) acc[a][b][m][n] = (f32x4){0.f, 0.f, 0.f, 0.f};
    bf16x8 At[4][2], B0[2][2], B1[2][2];
    const char* cA = (const char*)g.A + (size_t)cur.pm * tstepA; const char* cB = (const char*)g.Bt + (size_t)cur.pn * tstepB + (size_t)(cur.pm >> g.bsh) * g.bmul;
    PG8_STAGE(PG8_SB(0, 0), cB, voffB); PG8_STAGE(PG8_SB(0, 1), cB + hstepB, voffB); PG8_STAGE(PG8_SA(0, 0), cA, voffA); PG8_STAGE(PG8_SA(0, 1), cA + hstepA, voffA);
    if (wr == 1) PG8_BAR;
    PG8_WAIT_V(2); PG8_BAR;
    PG8_STAGE(PG8_SB(1, 0), cB + kstep, voffB); PG8_STAGE(PG8_SA(1, 0), cA + kstep, voffA); PG8_STAGE(PG8_SB(1, 1), cB + hstepB + kstep, voffB);
    PG8_WAIT_V(6); PG8_BAR;
    for (;;) {
        const bool has_next = S.next(ui + 1, nxt);
        const char* nA = has_next ? (const char*)g.A + (size_t)nxt.pm * tstepA : cA;
        const char* nB = has_next ? (const char*)g.Bt + (size_t)nxt.pn * tstepB + (size_t)(nxt.pm >> g.bsh) * g.bmul : cB;
        for (int t = 0; t < nt; t += 2) {
            const bool last = (t == nt - 2);
            const char* a1 = cA + (size_t)(t + 1) * kstep;
            const char* a2 = last ? nA : cA + (size_t)(t + 2) * kstep; const char* b2 = last ? nB : cB + (size_t)(t + 2) * kstep;
            const char* a3 = a2 + kstep; const char* b3 = b2 + kstep;
            PG8_LDB(B0, 0, 0); PG8_LDB(B1, 0, 1); PG8_SCHED; PG8_LDA(At, 0, 0); PG8_STAGE(PG8_SA(1, 1), a1 + hstepA, voffA);
            PG8_WAIT_V(8); PG8_WAIT_L(0); PG8_BAR; PG8_MMA(0, 0, At, B0); PG8_MMA(0, 1, At, B1); PG8_BAR; PG8_SCHED;
            PG8_LDA(At, 0, 1); PG8_STAGE(PG8_SB(0, 0), b2, voffB); PG8_STAGE(PG8_SB(0, 1), b2 + hstepB, voffB); PG8_STAGE(PG8_SA(0, 0), a2, voffA);
            PG8_WAIT_V(8); PG8_WAIT_L(0); PG8_BAR; PG8_MMA(1, 0, At, B0); PG8_MMA(1, 1, At, B1); PG8_BAR; PG8_SCHED;
            PG8_LDB(B0, 1, 0); PG8_LDB(B1, 1, 1); PG8_SCHED; PG8_LDA(At, 1, 0); PG8_STAGE(PG8_SA(0, 1), a2 + hstepA, voffA);
            PG8_WAIT_V(8); PG8_WAIT_L(0); PG8_BAR; PG8_MMA(0, 0, At, B0); PG8_MMA(0, 1, At, B1); PG8_BAR; PG8_SCHED;
            PG8_LDA(At, 1, 1); PG8_STAGE(PG8_SB(1, 0), b3, voffB); PG8_STAGE(PG8_SB(1, 1), b3 + hstepB, voffB); PG8_STAGE(PG8_SA(1, 0), a3, voffA);
            PG8_WAIT_V(8); PG8_WAIT_L(0); PG8_BAR; PG8_MMA(1, 0, At, B0); PG8_MMA(1, 1, At, B1); PG8_BAR; PG8_SCHED;
        }
        if (wr == 0) PG8_BAR;
        E(acc, cur, wr, wc, fr, fq);
        if (!has_next) break;
#pragma unroll
        for (int a = 0; a < 2; ++a)
#pragma unroll
            for (int b = 0; b < 2; ++b)
#pragma unroll
                for (int m = 0; m < 4; ++m)
#pragma unroll
                    for (int n = 0; n < 2; ++n) acc[a][b][m][n] = (f32x4){0.f, 0.f, 0.f, 0.f};
        cur = nxt; cA = nA; cB = nB; ++ui;
        if (wr == 1) PG8_BAR;
    }
    PG8_WAIT_V(0);
    PG8_BAR;
#undef PG8_SA
#undef PG8_SB
#undef PG8_STAGE
#undef PG8_LDA
#undef PG8_LDB
#undef PG8_MMA
#undef PG8_WAIT_V
#undef PG8_WAIT_L
#undef PG8_BAR
#undef PG8_SCHED
}
}

enum { EPI_GMLP1 = 0, EPI_POOL1 = 1, EPI_ATTN1 = 2, EPI_ATTNC = 3, EPI_RES = 4, EPI_BF16 = 5, EPI_F32 = 6 };
template <int MODE> struct Epi {
    static constexpr int mode = MODE;
    bf16_t *o0, *o1, *o2, *o3;
    float* stats;
    const float* gate;
    const float *xil, *xic; float *xol, *xoc;
    const float *rc, *rs;
    int ldc;
    const float* sumsq_in; const float* bias; int rowoff; int ctxonly;
    float* sumsq_out; bf16_t* hout; const float* gnext; const float* modnext;
    int xmode; const bf16_t* xb_in; bf16_t* xb_out;
    __device__ __forceinline__ void operator()(f32x4 (&acc)[2][2][4][2], const pg8::Unit& u, int wr, int wc, int fr, int fq) const {
        const int row0 = u.pm * 256 + wr * 64 + fr;
        if ((mode == EPI_GMLP1 || mode == EPI_POOL1 || mode == EPI_ATTN1 || mode == EPI_ATTNC) && sumsq_in != nullptr) {
            const int b = (ctxonly || u.pm >= ML / 256) ? 32 : (u.pm >> 3);
            const float* bp = bias + (size_t)b * ldc + u.pn * 256 + wc * 32 + fq * 8;
            f32x4 bv[2][2];
#pragma unroll
            for (int bj = 0; bj < 2; ++bj)
#pragma unroll
                for (int n = 0; n < 2; ++n) bv[bj][n] = *(const f32x4*)(bp + bj * 128 + 4 * n);
#pragma unroll
            for (int ai = 0; ai < 2; ++ai)
#pragma unroll
                for (int m = 0; m < 4; ++m) {
                    const float rsd = rsqrtf(sumsq_in[rowoff + row0 + ai * 128 + m * 16] * (1.0f / DM) + 1e-6f);
#pragma unroll
                    for (int bj = 0; bj < 2; ++bj)
#pragma unroll
                        for (int n = 0; n < 2; ++n) acc[ai][bj][m][n] = acc[ai][bj][m][n] * rsd + bv[bj][n];
                }
        }
        if (mode == EPI_GMLP1) {
            if (u.pn < 16) {
#pragma unroll
                for (int ai = 0; ai < 2; ++ai)
#pragma unroll
                    for (int m = 0; m < 4; ++m) {
                        const size_t row = (size_t)(row0 + ai * 128 + m * 16);
                        const f32x4 u0 = acc[ai][0][m][0], u1 = acc[ai][0][m][1], g0 = acc[ai][1][m][0], g1 = acc[ai][1][m][1];
                        u32x4 w;
                        { const f32x2 r = ugate2((f32x2){u0[0], u0[1]}, (f32x2){g0[0], g0[1]}); w.x = cvt_pk_bf16(r[0], r[1]); }
                        { const f32x2 r = ugate2((f32x2){u0[2], u0[3]}, (f32x2){g0[2], g0[3]}); w.y = cvt_pk_bf16(r[0], r[1]); }
                        { const f32x2 r = ugate2((f32x2){u1[0], u1[1]}, (f32x2){g1[0], g1[1]}); w.z = cvt_pk_bf16(r[0], r[1]); }
                        { const f32x2 r = ugate2((f32x2){u1[2], u1[3]}, (f32x2){g1[2], g1[3]}); w.w = cvt_pk_bf16(r[0], r[1]); }
                        *(u32x4*)(o0 + row * 2048 + u.pn * 128 + wc * 32 + fq * 8) = w;
                    }
            } else {
                const int g = u.pn - 16;
#pragma unroll
                for (int ai = 0; ai < 2; ++ai)
#pragma unroll
                    for (int m = 0; m < 4; ++m) {
                        const size_t row = (size_t)(row0 + ai * 128 + m * 16);
                        float s = 0.f, ss = 0.f;
#pragma unroll
                        for (int bj = 0; bj < 2; ++bj) {
                            float v[8];
#pragma unroll
                            for (int j = 0; j < 4; j += 2) { const f32x2 r0 = gelu2((f32x2){acc[ai][bj][m][0][j], acc[ai][bj][m][0][j + 1]}), r1 = gelu2((f32x2){acc[ai][bj][m][1][j], acc[ai][bj][m][1][j + 1]});
                                v[j] = r0[0]; v[j + 1] = r0[1]; v[4 + j] = r1[0]; v[5 + j] = r1[1]; }
#pragma unroll
                            for (int j = 0; j < 8; ++j) { s += v[j]; ss += v[j] * v[j]; }
                            u32x4 w; w.x = cvt_pk_bf16(v[0], v[1]); w.y = cvt_pk_bf16(v[2], v[3]); w.z = cvt_pk_bf16(v[4], v[5]); w.w = cvt_pk_bf16(v[6], v[7]);
                            *(u32x4*)(o1 + row * 2048 + g * 256 + bj * 128 + wc * 32 + fq * 8) = w;
                        }
                        { const int ln = fr + 16 * fq; s += shx(s, 16, ln); s += shx(s, 32, ln); ss += shx(ss, 16, ln); ss += shx(ss, 32, ln); }
                        if (fq == 0) *(f32x2*)(stats + (row * 32 + g * 4 + wc) * 2) = (f32x2){s, ss};
                    }
            }
        } else if (mode == EPI_POOL1) {
            const bool isg = u.pn >= 8; bf16_t* const o = isg ? o1 : o0; const int cb = (isg ? u.pn - 8 : u.pn) * 256 + wc * 32 + fq * 8;
#pragma unroll
            for (int ai = 0; ai < 2; ++ai)
#pragma unroll
                for (int m = 0; m < 4; ++m) {
                    const size_t row = (size_t)(row0 + ai * 128 + m * 16);
#pragma unroll
                    for (int bj = 0; bj < 2; ++bj) {
                        f32x4 v0 = acc[ai][bj][m][0], v1 = acc[ai][bj][m][1];
                        if (isg) {
#pragma unroll
                            for (int j = 0; j < 4; ++j) { v0[j] = silu_f(v0[j]); v1[j] = silu_f(v1[j]); }
                        }
                        u32x4 w; w.x = cvt_pk_bf16(v0[0], v0[1]); w.y = cvt_pk_bf16(v0[2], v0[3]); w.z = cvt_pk_bf16(v1[0], v1[1]); w.w = cvt_pk_bf16(v1[2], v1[3]);
                        *(u32x4*)(o + row * 2048 + cb + bj * 128) = w;
                    }
                }
        } else if (mode == EPI_ATTN1 || mode == EPI_ATTNC) {
            const bool ctx = (mode == EPI_ATTNC);
            const int sec = ctx ? (u.pn == 0 ? 1 : 2) : (u.pn < 4 ? 0 : (u.pn == 4 ? 1 : (u.pn == 5 ? 2 : 3)));
            if (sec <= 1) {
                const int j0 = 16 * (wc & 1) + 4 * fq;
                const float qs = (sec == 0) ? 0.125f : 1.0f;
#pragma unroll
                for (int ai = 0; ai < 2; ++ai)
#pragma unroll
                    for (int m = 0; m < 4; ++m) {
                        const int row = row0 + ai * 128 + m * 16;
                        f32x4 c4 = (f32x4){qs, qs, qs, qs}, s4 = (f32x4){0.f, 0.f, 0.f, 0.f};
                        if (!ctx) { const int s = row & (SEQ - 1); c4 = *(const f32x4*)(rc + s * 32 + j0) * qs; s4 = *(const f32x4*)(rs + s * 32 + j0) * qs; }
#pragma unroll
                        for (int bj = 0; bj < 2; ++bj) {
                            const f32x4 x1 = acc[ai][bj][m][0], x2 = acc[ai][bj][m][1];
                            const f32x4 a = x1 * c4 - x2 * s4, b = x2 * c4 + x1 * s4;
                            const int hl = 2 * bj + (wc >> 1);
                            bf16_t* p = (sec == 0) ? (o0 + (size_t)row * 1024 + (u.pn * 4 + hl) * 64 + j0) : ((ctx ? o0 : o1) + (size_t)row * 256 + hl * 64 + j0);
                            *(u32x2*)p = (u32x2){cvt_pk_bf16(a[0], a[1]), cvt_pk_bf16(a[2], a[3])};
                            *(u32x2*)(p + 32) = (u32x2){cvt_pk_bf16(b[0], b[1]), cvt_pk_bf16(b[2], b[3])};
                        }
                    }
            } else if (sec == 2) {
                bf16_t* const vt = ctx ? o1 : o2; const int lsh = ctx ? 8 : 11, L = 1 << lsh;
#pragma unroll
                for (int ai = 0; ai < 2; ++ai)
#pragma unroll
                    for (int m = 0; m < 4; ++m) {
                        const int row = row0 + ai * 128 + m * 16, b = row >> lsh, t = row & (L - 1);
#pragma unroll
                        for (int bj = 0; bj < 2; ++bj) {
                            const int kvh = 2 * bj + (wc >> 1);
                            bf16_t* p = vt + ((size_t)((b * 4 + kvh) * 64 + 32 * (wc & 1) + 8 * fq) << lsh) + t;
#pragma unroll
                            for (int n = 0; n < 2; ++n)
#pragma unroll
                                for (int j = 0; j < 4; ++j) p[(size_t)(4 * n + j) << lsh] = (bf16_t)(cvt_pk_bf16(acc[ai][bj][m][n][j], 0.f) & 0xffffu);
                        }
                    }
            } else {
                const int cb = (u.pn - 6) * 256 + wc * 32 + fq * 8;
#pragma unroll
                for (int ai = 0; ai < 2; ++ai)
#pragma unroll
                    for (int m = 0; m < 4; ++m) {
                        const size_t row = (size_t)(row0 + ai * 128 + m * 16);
#pragma unroll
                        for (int bj = 0; bj < 2; ++bj) {
                            const f32x4 v0 = acc[ai][bj][m][0], v1 = acc[ai][bj][m][1];
                            u32x4 w; w.x = cvt_pk_bf16(silu_f(v0[0]), silu_f(v0[1])); w.y = cvt_pk_bf16(silu_f(v0[2]), silu_f(v0[3]));
                            w.z = cvt_pk_bf16(silu_f(v1[0]), silu_f(v1[1])); w.w = cvt_pk_bf16(silu_f(v1[2]), silu_f(v1[3]));
                            *(u32x4*)(o3 + row * 1024 + cb + bj * 128) = w;
                        }
                    }
            }
        } else if (mode == EPI_RES) {
            const bool lat = u.pm < ML / 256;
            const size_t tb = (lat ? (size_t)u.pm : (size_t)(u.pm - ML / 256)) * 256 * DM;
            const size_t tg = (size_t)u.pm * 256 * DM;
            const float* xi = (lat ? xil : xic) + tb; float* xo = xol + tb;
            const bf16_t* xbi = xb_in + tg; bf16_t* xbo = xb_out + tg;
            const int bb = lat ? (u.pm >> 3) : 32;
            const int colb = u.pn * 256 + wc * 32 + fq * 8;
            const float* gp = gate + bb * 3072 + colb;
            const unsigned lo = (unsigned)((wr * 64 + fr) * DM + colb) * 4u;
            f32x4 gv[2][2], gn[2][2];
#pragma unroll
            for (int bj = 0; bj < 2; ++bj)
#pragma unroll
                for (int n = 0; n < 2; ++n) {
                    gv[bj][n] = *(const f32x4*)(gp + bj * 128 + 4 * n);
                    if (hout) gn[bj][n] = *(const f32x4*)(gnext + colb + bj * 128 + 4 * n) * (*(const f32x4*)(modnext + bb * 3072 + 1024 + colb + bj * 128 + 4 * n) + 1.0f);
                }
            bf16_t* hb = hout + tg;
#define RES_BODY(AI, M, XV0, XV1, BJ) do { \
                        f32x4 t[2]; t[0] = (XV0) + gv[BJ][0] * acc[AI][BJ][M][0]; t[1] = (XV1) + gv[BJ][1] * acc[AI][BJ][M][1]; \
                        if (xmode == 2) { \
                            *(f32x4*)((char*)xo + lo + (unsigned)((((AI) * 128 + (M) * 16) * DM + (BJ) * 128) * 4)) = t[0]; \
                            *(f32x4*)((char*)xo + lo + (unsigned)((((AI) * 128 + (M) * 16) * DM + (BJ) * 128 + 4) * 4)) = t[1]; \
                        } else { \
                            *(u32x4*)((char*)xbo + (lo >> 1) + (unsigned)((((AI) * 128 + (M) * 16) * DM + (BJ) * 128) * 2)) = (u32x4){cvt_pk_bf16(t[0][0], t[0][1]), cvt_pk_bf16(t[0][2], t[0][3]), cvt_pk_bf16(t[1][0], t[1][1]), cvt_pk_bf16(t[1][2], t[1][3])}; \
                        } \
                        if (sumsq_out) ss += t[0][0] * t[0][0] + t[0][1] * t[0][1] + t[0][2] * t[0][2] + t[0][3] * t[0][3] + t[1][0] * t[1][0] + t[1][1] * t[1][1] + t[1][2] * t[1][2] + t[1][3] * t[1][3]; \
                        if (hout) { const f32x4 h0 = t[0] * gn[BJ][0], h1 = t[1] * gn[BJ][1]; \
                            *(u32x4*)((char*)hb + (lo >> 1) + (unsigned)((((AI) * 128 + (M) * 16) * DM + (BJ) * 128) * 2)) = (u32x4){cvt_pk_bf16(h0[0], h0[1]), cvt_pk_bf16(h0[2], h0[3]), cvt_pk_bf16(h1[0], h1[1]), cvt_pk_bf16(h1[2], h1[3])}; } \
                    } while (0)
#define RES_ROWSUM(AI, M) do { if (sumsq_out) { const int ln = fr + 16 * fq; ss += shx(ss, 16, ln); ss += shx(ss, 32, ln); \
                        if (fq == 0) (void)__hip_atomic_fetch_add(sumsq_out + row0 + (AI) * 128 + (M) * 16, ss, __ATOMIC_RELAXED, __HIP_MEMORY_SCOPE_AGENT); } } while (0)
            if (xmode == 0) {
#pragma unroll
                for (int am = 0; am < 4; ++am) {
                    const int ai = am >> 1, mb = (am & 1) * 2;
                    f32x4 xv[2][2][2];
#pragma unroll
                    for (int m2 = 0; m2 < 2; ++m2)
#pragma unroll
                        for (int bj = 0; bj < 2; ++bj)
#pragma unroll
                            for (int n = 0; n < 2; ++n) xv[m2][bj][n] = *(const f32x4*)((const char*)xi + lo + (unsigned)(((ai * 128 + (mb + m2) * 16) * DM + bj * 128 + 4 * n) * 4));
                    __builtin_amdgcn_sched_barrier(0);
#pragma unroll
                    for (int m2 = 0; m2 < 2; ++m2) {
                        float ss = 0.f;
#pragma unroll
                        for (int bj = 0; bj < 2; ++bj) RES_BODY(ai, mb + m2, xv[m2][bj][0], xv[m2][bj][1], bj);
                        RES_ROWSUM(ai, mb + m2);
                    }
                    __builtin_amdgcn_sched_barrier(0);
                }
            } else {
#pragma unroll
                for (int ai = 0; ai < 2; ++ai) {
                    u32x4 xw[4][2];
#pragma unroll
                    for (int m = 0; m < 4; ++m)
#pragma unroll
                        for (int bj = 0; bj < 2; ++bj) xw[m][bj] = *(const u32x4*)((const char*)xbi + (lo >> 1) + (unsigned)(((ai * 128 + m * 16) * DM + bj * 128) * 2));
                    __builtin_amdgcn_sched_barrier(0);
#pragma unroll
                    for (int m = 0; m < 4; ++m) {
                        float ss = 0.f;
#pragma unroll
                        for (int bj = 0; bj < 2; ++bj) {
                            const u32x4 w = xw[m][bj];
                            RES_BODY(ai, m, ((f32x4){bf_lo(w.x), bf_hi(w.x), bf_lo(w.y), bf_hi(w.y)}), ((f32x4){bf_lo(w.z), bf_hi(w.z), bf_lo(w.w), bf_hi(w.w)}), bj);
                        }
                        RES_ROWSUM(ai, m);
                    }
                    __builtin_amdgcn_sched_barrier(0);
                }
            }
#undef RES_BODY
#undef RES_ROWSUM
        } else if (mode == EPI_F32) {
            if (wr == 0) {
#pragma unroll
                for (int m = 0; m < 4; ++m)
#pragma unroll
                    for (int bj = 0; bj < 2; ++bj)
#pragma unroll
                        for (int n = 0; n < 2; ++n) *(f32x4*)((float*)o0 + (size_t)(m * 16 + fr) * ldc + u.pn * 256 + bj * 128 + wc * 32 + fq * 8 + 4 * n) = acc[0][bj][m][n];
            }
        } else {
            const int cb = u.pn * 256 + wc * 32 + fq * 8;
#pragma unroll
            for (int ai = 0; ai < 2; ++ai)
#pragma unroll
                for (int m = 0; m < 4; ++m) {
                    const size_t row = (size_t)(row0 + ai * 128 + m * 16);
#pragma unroll
                    for (int bj = 0; bj < 2; ++bj) {
                        const f32x4 v0 = acc[ai][bj][m][0], v1 = acc[ai][bj][m][1];
                        u32x4 w; w.x = cvt_pk_bf16(v0[0], v0[1]); w.y = cvt_pk_bf16(v0[2], v0[3]); w.z = cvt_pk_bf16(v1[0], v1[1]); w.w = cvt_pk_bf16(v1[2], v1[3]);
                        *(u32x4*)(o0 + row * ldc + cb + bj * 128) = w;
                    }
                }
        }
    }
};

struct Params {
    const float *x, *c, *ctx, *c_ctx, *ada_w, *ada_b, *norm_g, *final_g;
    const float *gmlp_w_in, *gmlp_vn_g, *gmlp_vn_b, *gmlp_w_s, *gmlp_b_s, *gmlp_w_out;
    const float *pool_w_in, *pool_w_grp, *pool_scale, *pool_w_out;
    const float *attn_w_in, *attn_sink, *attn_w_out;
    float* out; unsigned char* ws;
    int ph_lo, ph_hi;
};

__device__ __forceinline__ void prep_mod(int wv, LAS unsigned char* lds, const Params& P, int item) {
    const int tid = get_tid(wv), wave = tid >> 6, lane = tid & 63;
    const int layer = item / 48, nb = item % 48, col = nb * 64 + lane;
    LAS float* sc = (LAS float*)lds;
    LAS float* red = (LAS float*)(lds + 256 * 36 * 4);
    float acc[33];
#pragma unroll
    for (int b = 0; b < 33; ++b) acc[b] = 0.f;
    const float* W = P.ada_w + (size_t)layer * 1024 * 3072;
    for (int kc = 0; kc < 4; ++kc) {
        __syncthreads();
        for (int idx = tid; idx < 33 * 256; idx += 512) { const int b = idx >> 8, kk = idx & 255; const float v = (b < 32) ? P.c[b * 1024 + kc * 256 + kk] : P.c_ctx[kc * 256 + kk]; sc[kk * 36 + b] = v / (1.0f + __expf(-v)); }
        __syncthreads();
        for (int k2 = 0; k2 < 32; ++k2) {
            const int kk = wave * 32 + k2;
            const float wv = W[(size_t)(kc * 256 + kk) * 3072 + col];
#pragma unroll
            for (int b4 = 0; b4 < 8; ++b4) { const f32x4 s4 = *(const LAS f32x4*)(sc + kk * 36 + b4 * 4); acc[b4 * 4 + 0] += s4[0] * wv; acc[b4 * 4 + 1] += s4[1] * wv; acc[b4 * 4 + 2] += s4[2] * wv; acc[b4 * 4 + 3] += s4[3] * wv; }
            acc[32] += sc[kk * 36 + 32] * wv;
        }
    }
#pragma unroll
    for (int b = 0; b < 33; ++b) red[(wave * 33 + b) * 64 + lane] = acc[b];
    __syncthreads();
    for (int idx = tid; idx < 33 * 64; idx += 512) {
        const int b = idx >> 6, l = idx & 63; float s = 0.f;
#pragma unroll
        for (int w = 0; w < 8; ++w) s += red[(w * 33 + b) * 64 + l];
        const int cc = nb * 64 + l;
        ((float*)(P.ws + WS_MOD))[(size_t)layer * MODSZ + b * 3072 + cc] = s + P.ada_b[layer * 3072 + cc];
    }
    __syncthreads();
}

struct ConvTile { const float* src; bf16_t* dst; int ldn, K, L0, P0, k0, rope; };
__device__ __forceinline__ void conv_decode(const Params& P, int t, ConvTile& c) {
    unsigned char* ws = P.ws;
    c.rope = 0;
    if (t < 3072) {
        const int j = t / 1536, tt = t % 1536, kt = tt / 96, nt = tt % 96, p0 = nt * 64;
        c.src = P.gmlp_w_in + (size_t)j * 1024 * 6144; c.dst = (bf16_t*)(ws + (j ? WS_GIN1 : WS_GIN0)); c.ldn = 6144; c.K = 1024; c.k0 = kt * 64; c.P0 = p0;
        c.L0 = (p0 < 4096) ? (((p0 & 255) >= 128 ? 4096 : 0) + 128 * (p0 >> 8) + (p0 & 127)) : (2048 + (p0 - 4096));
        return;
    }
    t -= 3072;
    if (t < 1024) {
        const int j = t / 512, tt = t % 512, kt = tt / 16, nt = tt % 16;
        c.src = P.gmlp_w_out + (size_t)j * 2048 * 1024; c.dst = (bf16_t*)(ws + (j ? WS_GOUT1 : WS_GOUT0)); c.ldn = 1024; c.K = 2048; c.k0 = kt * 64; c.P0 = nt * 64; c.L0 = nt * 64; return;
    }
    t -= 1024;
    if (t < 512) {
        const int kt = t / 32, nt = t % 32;
        c.src = P.pool_w_in; c.dst = (bf16_t*)(ws + WS_PINT); c.ldn = 4096; c.K = 1024; c.k0 = kt * 64; c.P0 = 2048 + nt * 64; c.L0 = 2048 + nt * 64; return;
    }
    t -= 512;
    if (t < 256) {
        const int g = t / 64, tt = t % 64, kt = tt / 8, nt = tt % 8;
        c.src = P.pool_w_grp + (size_t)g * 512 * 512; c.dst = (bf16_t*)(ws + WS_PGRPT) + (size_t)g * 512 * 512; c.ldn = 512; c.K = 512; c.k0 = kt * 64; c.P0 = nt * 64; c.L0 = nt * 64; return;
    }
    t -= 256;
    if (t < 512) {
        const int kt = t / 16, nt = t % 16;
        c.src = P.pool_w_out; c.dst = (bf16_t*)(ws + WS_POUT); c.ldn = 1024; c.K = 2048; c.k0 = kt * 64; c.P0 = nt * 64; c.L0 = nt * 64; return;
    }
    t -= 512;
    if (t < 640) {
        const int kt = t / 40, nt = t % 40;
        c.src = P.attn_w_in; c.dst = (bf16_t*)(ws + WS_AIN); c.ldn = 2560; c.K = 1024; c.k0 = kt * 64; c.P0 = nt * 64; c.L0 = nt * 64; c.rope = (nt < 20); return;
    }
    t -= 640;
    {
        const int kt = t / 16, nt = t % 16;
        c.src = P.attn_w_out; c.dst = (bf16_t*)(ws + WS_AOUT); c.ldn = 1024; c.K = 1024; c.k0 = kt * 64; c.P0 = nt * 64; c.L0 = nt * 64; return;
    }
}
constexpr int N_CONV_TILES = 3072 + 1024 + 512 + 256 + 512 + 640 + 256;

__device__ __forceinline__ void prep_phase(int wv, LAS unsigned char* lds, const Params& P, int part) {
    const int tid = get_tid(wv), G = gridDim.x, bid = blockIdx.x;
    if (part == 0) for (int item = bid; item < 192; item += G) prep_mod(wv, lds, P, item);
    if (part == 0) {
        float* rc = (float*)(P.ws + WS_ROPEC); float* rs = (float*)(P.ws + WS_ROPES);
        for (int i = bid * 512 + tid; i < 2048 * 32; i += G * 512) {
            const int s = i >> 5, j = i & 31; const float pos = (float)((j < 16) ? (s >> 6) : (s & 63));
            const float inv = exp2f(-(float)(j & 15) * (13.287712379549449f / 16.0f));
            const float ang = pos * inv, tr = ang * 0.15915494309189535f;
            rc[i] = __builtin_amdgcn_cosf(tr); rs[i] = __builtin_amdgcn_sinf(tr);
        }
        bf16_t* pn = (bf16_t*)(P.ws + WS_PINNT);
        for (int i = bid * 512 + tid; i < 1024 * 256; i += G * 512) {
            const int r = i >> 8, c8 = i & 255; const float* s = P.pool_w_in + (size_t)r * 4096 + c8 * 8;
            const f32x4 a = *(const f32x4*)s, b = *(const f32x4*)(s + 4);
            *(u32x4*)(pn + (size_t)r * 2048 + c8 * 8) = (u32x4){cvt_pk_bf16(a[0], a[1]), cvt_pk_bf16(a[2], a[3]), cvt_pk_bf16(b[0], b[1]), cvt_pk_bf16(b[2], b[3])};
        }
        { f32x4* sq = (f32x4*)(P.ws + WS_SUMSQ); for (int i = bid * 512 + tid; i < 3 * MT / 4; i += G * 512) sq[i] = (f32x4){0.f, 0.f, 0.f, 0.f}; }
        bf16_t* gw = (bf16_t*)(P.ws + WS_GWS);
        for (int i = bid * 512 + tid; i < 2 * 8 * 128 * 128 / 8; i += G * 512) {
            const float* s = P.gmlp_w_s + (size_t)i * 8; const f32x4 a = *(const f32x4*)s, b = *(const f32x4*)(s + 4);
            *(u32x4*)(gw + (size_t)i * 8) = (u32x4){cvt_pk_bf16(a[0], a[1]), cvt_pk_bf16(a[2], a[3]), cvt_pk_bf16(b[0], b[1]), cvt_pk_bf16(b[2], b[3])};
        }
    }
    if (part == 0) return;
    LAS float* tb = (LAS float*)lds;
    const int kr = tid >> 4, nc4 = tid & 15;
    const int pr = tid >> 3, kq = tid & 7;
    for (int t0 = bid * 4; t0 < N_CONV_TILES; t0 += G * 4) {
        f32x4 v[4][2];
#pragma unroll
        for (int s = 0; s < 4; ++s) {
            ConvTile c; conv_decode(P, (t0 + s < N_CONV_TILES) ? t0 + s : t0, c);
#pragma unroll
            for (int j = 0; j < 2; ++j) v[s][j] = *(const f32x4*)(c.src + (size_t)(c.k0 + kr + 32 * j) * c.ldn + c.L0 + nc4 * 4);
        }
        __syncthreads();
#pragma unroll
        for (int s = 0; s < 4; ++s)
#pragma unroll
            for (int j = 0; j < 2; ++j)
#pragma unroll
                for (int e = 0; e < 4; ++e) tb[s * 4160 + (kr + 32 * j) * 65 + nc4 * 4 + e] = v[s][j][e];
        __syncthreads();
#pragma unroll
        for (int s = 0; s < 4; ++s) {
            if (t0 + s < N_CONV_TILES) {
                ConvTile c; conv_decode(P, t0 + s, c);
                const int lj = c.rope ? (4 * (pr >> 3) + (pr & 3) + 32 * ((pr >> 2) & 1)) : pr;
                float f[8];
#pragma unroll
                for (int e = 0; e < 8; ++e) f[e] = tb[s * 4160 + (kq * 8 + e) * 65 + lj];
                *(u32x4*)(c.dst + (size_t)(c.P0 + pr) * c.K + c.k0 + kq * 8) = (u32x4){cvt_pk_bf16(f[0], f[1]), cvt_pk_bf16(f[2], f[3]), cvt_pk_bf16(f[4], f[5]), cvt_pk_bf16(f[6], f[7])};
            }
        }
    }
    __syncthreads();
}

__device__ __forceinline__ void shift16_phase(int wv, const float* mod, bf16_t* S16) {
    const int tid = get_tid(wv);
    for (int i = blockIdx.x * 512 + tid; i < 3 * 256 * 128; i += gridDim.x * 512) {
        const int l = i >> 15, r = (i >> 7) & 255, c8 = i & 127;
        u32x4 w = (u32x4){0u, 0u, 0u, 0u};
        if (r < 33) { const float* s = mod + (size_t)(l + 1) * MODSZ + r * 3072 + c8 * 8; const f32x4 a = *(const f32x4*)s, b = *(const f32x4*)(s + 4);
            w = (u32x4){cvt_pk_bf16(a[0], a[1]), cvt_pk_bf16(a[2], a[3]), cvt_pk_bf16(b[0], b[1]), cvt_pk_bf16(b[2], b[3])}; }
        *(u32x4*)(S16 + (size_t)i * 8) = w;
    }
}

__device__ __forceinline__ void norm_phase(int wv, int vcu, bool rev, const float* xl, const float* xc, int nrows, const float* g, const float* modl, bf16_t* H) {
    const int tid_ = get_tid(wv); const int lane = tid_ & 63;
    f32x4 gv[4];
#pragma unroll
    for (int j = 0; j < 2; ++j) { gv[2 * j] = *(const f32x4*)(g + 512 * j + lane * 8); gv[2 * j + 1] = *(const f32x4*)(g + 512 * j + lane * 8 + 4); }
    constexpr int NR = 4;
    const int nun = nrows >> 5;
    for (int uu = vcu; uu < nun; uu += gridDim.x) {
        const int r0 = unit_remap(uu, nun, rev) * 32 + (tid_ >> 6) * 4; const int nw = 1;
        f32x4 v[NR][4];
#pragma unroll
        for (int q = 0; q < NR; ++q) {
            const int r = min(r0 + q * nw, nrows - 1);
            const float* xp = (r < ML) ? xl + (size_t)r * DM : xc + (size_t)(r - ML) * DM;
#pragma unroll
            for (int j = 0; j < 2; ++j) { v[q][2 * j] = *(const f32x4*)(xp + 512 * j + lane * 8); v[q][2 * j + 1] = *(const f32x4*)(xp + 512 * j + lane * 8 + 4); }
        }
#pragma unroll
        for (int q = 0; q < NR; ++q) {
            const int r = r0 + q * nw;
            if (r < nrows) {
                const float* mp = modl + ((r < ML) ? (r >> 11) : 32) * 3072;
                float ss = 0.f;
#pragma unroll
                for (int j = 0; j < 4; ++j) ss += v[q][j][0] * v[q][j][0] + v[q][j][1] * v[q][j][1] + v[q][j][2] * v[q][j][2] + v[q][j][3] * v[q][j][3];
                ss = wave_sum(ss, lane);
                const float rstd = rsqrtf(ss * (1.0f / DM) + 1e-6f);
#pragma unroll
                for (int j = 0; j < 2; ++j) {
                    const int k = 512 * j + lane * 8;
                    const f32x4 sh0 = *(const f32x4*)(mp + k), sh1 = *(const f32x4*)(mp + k + 4), sc0 = *(const f32x4*)(mp + 1024 + k), sc1 = *(const f32x4*)(mp + 1024 + k + 4);
                    const f32x4 a = v[q][2 * j] * rstd * gv[2 * j] * (sc0 + 1.0f) + sh0, b = v[q][2 * j + 1] * rstd * gv[2 * j + 1] * (sc1 + 1.0f) + sh1;
                    *(u32x4*)(H + (size_t)r * DM + k) = (u32x4){cvt_pk_bf16(a[0], a[1]), cvt_pk_bf16(a[2], a[3]), cvt_pk_bf16(b[0], b[1]), cvt_pk_bf16(b[2], b[3])};
                }
            }
        }
    }
}
__device__ __forceinline__ void final_phase(int wv, int vcu, bool rev, const bf16_t* x, float* out, const float* g) {
    const int tid_ = get_tid(wv); const int lane = tid_ & 63;
    f32x4 gv[4];
#pragma unroll
    for (int j = 0; j < 2; ++j) { gv[2 * j] = *(const f32x4*)(g + 512 * j + lane * 8); gv[2 * j + 1] = *(const f32x4*)(g + 512 * j + lane * 8 + 4); }
    constexpr int NR = 4;
    const int nun = ML >> 5;
    for (int uu = vcu; uu < nun; uu += gridDim.x) {
        const int r0 = unit_remap(uu, nun, rev) * 32 + (tid_ >> 6) * 4;
        u32x4 w[NR][2];
#pragma unroll
        for (int q = 0; q < NR; ++q) {
            const bf16_t* xp = x + (size_t)(r0 + q) * DM;
#pragma unroll
            for (int j = 0; j < 2; ++j) w[q][j] = *(const u32x4*)(xp + 512 * j + lane * 8);
        }
#pragma unroll
        for (int q = 0; q < NR; ++q) {
            float* xp = out + (size_t)(r0 + q) * DM;
            f32x4 v[4];
#pragma unroll
            for (int j = 0; j < 2; ++j) { const u32x4 ww = w[q][j]; v[2 * j] = (f32x4){bf_lo(ww.x), bf_hi(ww.x), bf_lo(ww.y), bf_hi(ww.y)}; v[2 * j + 1] = (f32x4){bf_lo(ww.z), bf_hi(ww.z), bf_lo(ww.w), bf_hi(ww.w)}; }
            float ss = 0.f;
#pragma unroll
            for (int j = 0; j < 4; ++j) ss += v[j][0] * v[j][0] + v[j][1] * v[j][1] + v[j][2] * v[j][2] + v[j][3] * v[j][3];
            ss = wave_sum(ss, lane);
            const float rstd = rsqrtf(ss * (1.0f / DM) + 1e-6f);
#pragma unroll
            for (int j = 0; j < 2; ++j) { *(f32x4*)(xp + 512 * j + lane * 8) = v[2 * j] * rstd * gv[2 * j]; *(f32x4*)(xp + 512 * j + lane * 8 + 4) = v[2 * j + 1] * rstd * gv[2 * j + 1]; }
        }
    }
}

__device__ __forceinline__ void spatial_phase(int wv, int vcu, bool rev, LAS unsigned char* lds, int nchunks, const bf16_t* UG, const bf16_t* GV, const float* stats, const bf16_t* WS16, const float* vn_g, const float* vn_b, const float* b_s, bf16_t* Y) {
    const int tid = get_tid(wv), wave = __builtin_amdgcn_readfirstlane(tid >> 6), lane = tid & 63, fr = lane & 15, fq = lane >> 4, wr = wave >> 2, wc = wave & 3;
    LAS f32x2* st = (LAS f32x2*)lds;
    LAS unsigned char* img = lds + 1024;
    LAS unsigned char* ugt = lds + 1024 + 65536;
    const int nunits = nchunks * 8;
    const int c8 = tid & 31, q0 = tid >> 5;
    u32x4 raw[8], ugr[8];
    if (vcu < nunits) {
        const int u = unit_remap(vcu, nunits, rev); const int g = u & 7; const size_t row0 = (size_t)(u >> 3) * 128;
#pragma unroll
        for (int it = 0; it < 8; ++it) { raw[it] = *(const u32x4*)(GV + (row0 + q0 + 16 * it) * 2048 + g * 256 + c8 * 8); ugr[it] = *(const u32x4*)(UG + (row0 + q0 + 16 * it) * 2048 + g * 256 + c8 * 8); }
    }
    for (int uu = vcu; uu < nunits; uu += gridDim.x) {
        const int u = unit_remap(uu, nunits, rev);
        const int g = u & 7, ch = u >> 3; const size_t row0 = (size_t)ch * 128;
        bf16x8 wf[4][4];
        {
            const bf16_t* wp = WS16 + (size_t)g * 16384 + (size_t)(wr * 64 + fr) * 128 + fq * 8;
#pragma unroll
            for (int ks = 0; ks < 4; ++ks)
#pragma unroll
                for (int m = 0; m < 4; ++m) wf[ks][m] = *(const bf16x8*)(wp + m * 16 * 128 + ks * 32);
        }
        {
            const int r = tid >> 2, part = tid & 3; const f32x4* sp = (const f32x4*)(stats + ((row0 + r) * 32 + part * 8) * 2);
            float s = 0.f, ss = 0.f;
#pragma unroll
            for (int i = 0; i < 4; ++i) { const f32x4 v = sp[i]; s += v[0] + v[2]; ss += v[1] + v[3]; }
            s += shx(s, 1, lane); s += shx(s, 2, lane); ss += shx(ss, 1, lane); ss += shx(ss, 2, lane);
            const float mean = s * (1.0f / 2048.0f), var = ss * (1.0f / 2048.0f) - mean * mean;
            if (part == 0) st[r] = (f32x2){mean, rsqrtf(fmaxf(var, 0.f) + 1e-6f)};
        }
#pragma unroll
        for (int it = 0; it < 8; ++it) *(LAS u32x4*)(ugt + (q0 + 16 * it) * 528 + c8 * 16) = ugr[it];
        __syncthreads();
        {
            const int cg = g * 256 + c8 * 8;
            const f32x4 G0 = *(const f32x4*)(vn_g + cg), G1 = *(const f32x4*)(vn_g + cg + 4), B0 = *(const f32x4*)(vn_b + cg), B1 = *(const f32x4*)(vn_b + cg + 4);
#pragma unroll
            for (int it = 0; it < 8; ++it) {
                const int q = q0 + 16 * it; const f32x2 ms = st[q]; const float mu = ms[0], rs = ms[1];
                const u32x4 w = raw[it]; u32x4 o;
                o.x = cvt_pk_bf16((bf_lo(w.x) - mu) * rs * G0[0] + B0[0], (bf_hi(w.x) - mu) * rs * G0[1] + B0[1]);
                o.y = cvt_pk_bf16((bf_lo(w.y) - mu) * rs * G0[2] + B0[2], (bf_hi(w.y) - mu) * rs * G0[3] + B0[3]);
                o.z = cvt_pk_bf16((bf_lo(w.z) - mu) * rs * G1[0] + B1[0], (bf_hi(w.z) - mu) * rs * G1[1] + B1[1]);
                o.w = cvt_pk_bf16((bf_lo(w.w) - mu) * rs * G1[2] + B1[2], (bf_hi(w.w) - mu) * rs * G1[3] + B1[3]);
                const int sw = (q & 3) | (((q >> 3) & 1) << 2);
                *(LAS u32x4*)(img + q * 512 + (((2 * c8) ^ (4 * sw)) * 8)) = o;
            }
        }
        __syncthreads();
        if (uu + (int)gridDim.x < nunits) {
            const int un = unit_remap(uu + gridDim.x, nunits, rev); const int gn = un & 7; const size_t rown = (size_t)(un >> 3) * 128;
#pragma unroll
            for (int it = 0; it < 8; ++it) { raw[it] = *(const u32x4*)(GV + (rown + q0 + 16 * it) * 2048 + gn * 256 + c8 * 8); ugr[it] = *(const u32x4*)(UG + (rown + q0 + 16 * it) * 2048 + gn * 256 + c8 * 8); }
        }
        f32x4 acc[4][4];
#pragma unroll
        for (int m = 0; m < 4; ++m)
#pragma unroll
            for (int n = 0; n < 4; ++n) acc[m][n] = (f32x4){0.f, 0.f, 0.f, 0.f};
        const int sw = (fr >> 2) | ((fq & 1) << 2);
#pragma unroll
        for (int ks = 0; ks < 4; ++ks) {
            bf16x8 vf[4];
#pragma unroll
            for (int n = 0; n < 4; ++n) {
                const int R = ks * 32 + 8 * fq + (fr >> 2), chunk = wc * 16 + n * 4 + (fr & 3);
                LAS unsigned char* a = img + R * 512 + ((chunk ^ (4 * sw)) * 8);
                const s16x4 lo = __builtin_amdgcn_ds_read_tr16_b64_v4i16((LAS s16x4*)a), hi = __builtin_amdgcn_ds_read_tr16_b64_v4i16((LAS s16x4*)(a + 2048));
                vf[n] = (bf16x8){lo[0], lo[1], lo[2], lo[3], hi[0], hi[1], hi[2], hi[3]};
            }
#pragma unroll
            for (int m = 0; m < 4; ++m)
#pragma unroll
                for (int n = 0; n < 4; ++n) acc[m][n] = __builtin_amdgcn_mfma_f32_16x16x32_bf16(vf[n], wf[ks][m], acc[m][n], 0, 0, 0);
        }
#pragma unroll
        for (int m = 0; m < 4; ++m) {
            const int p = wr * 64 + m * 16 + fr; const float bs = b_s[g * 128 + p];
#pragma unroll
            for (int n = 0; n < 4; ++n) {
                LAS u32x2* tp = (LAS u32x2*)(ugt + p * 528 + (wc * 64 + n * 16 + 4 * fq) * 2);
                const u32x2 ug = *tp; const f32x4 s = acc[m][n] + bs;
                *tp = (u32x2){cvt_pk_bf16(bf_lo(ug.x) * s[0], bf_hi(ug.x) * s[1]), cvt_pk_bf16(bf_lo(ug.y) * s[2], bf_hi(ug.y) * s[3])};
            }
        }
        __syncthreads();
#pragma unroll
        for (int it = 0; it < 8; ++it) *(u32x4*)(Y + (row0 + q0 + 16 * it) * 2048 + g * 256 + c8 * 8) = *(const LAS u32x4*)(ugt + (q0 + 16 * it) * 528 + c8 * 16);
        __syncthreads();
    }
}

__device__ __forceinline__ void pool_phase(int wv, int vcu, bool rev, LAS unsigned char* lds, const bf16_t* Z, const bf16_t* SG, const float* scale, bf16_t* Y) {
    const int tid = get_tid(wv);
    const int nunits = (MT / 128) * 8;
    u32x4 zr[9];
#define POOL_GEOM(uidx) const int u_ = unit_remap((uidx), nunits, rev); const int cb = u_ & 7, row0 = (u_ >> 3) * 128; int seq0, L; \
        if (row0 < ML) { seq0 = row0 & ~(SEQ - 1); L = SEQ; } else { seq0 = ML + ((row0 - ML) & ~(LC - 1)); L = LC; } const int t0 = row0 - seq0;
#define POOL_LOADZ() _Pragma("unroll") for (int it = 0; it < 9; ++it) { const int idx = tid + 512 * it, rr = idx >> 5, c8_ = idx & 31, t = t0 - 8 + rr; \
            zr[it] = (u32x4){0u, 0u, 0u, 0u}; if (t >= 0 && t < L) zr[it] = *(const u32x4*)(Z + (size_t)(seq0 + t) * 2048 + cb * 256 + c8_ * 8); }
    if (vcu < nunits) { POOL_GEOM(vcu) POOL_LOADZ() }
    for (int uu = vcu; uu < nunits; uu += gridDim.x) {
        POOL_GEOM(uu)
        const int hw = 1 << (cb >> 1);
        const int c8 = tid & 31, strip = tid >> 5, cg = cb * 256 + c8 * 8, tt0 = strip * 8;
        u32x4 sgv[8];
#pragma unroll
        for (int i = 0; i < 8; ++i) sgv[i] = *(const u32x4*)(SG + (size_t)(row0 + tt0 + i) * 2048 + cg);
#pragma unroll
        for (int it = 0; it < 9; ++it) { const int idx = tid + 512 * it; *(LAS u32x4*)(lds + (idx >> 5) * 512 + (idx & 31) * 16) = zr[it]; }
        __syncthreads();
        if (uu + (int)gridDim.x < nunits) {
            const int cb0 = cb, row00 = row0, t00 = t0, L0 = L, seq00 = seq0; (void)cb0; (void)row00; (void)t00; (void)L0; (void)seq00;
            { POOL_GEOM(uu + gridDim.x) POOL_LOADZ() }
        }
        const f32x4 sc0 = *(const f32x4*)(scale + cg), sc1 = *(const f32x4*)(scale + cg + 4);
        float sum[8];
#pragma unroll
        for (int e = 0; e < 8; ++e) sum[e] = 0.f;
        for (int rr = tt0 + 8 - hw; rr < tt0 + 8 + hw; ++rr) {
            const u32x4 w = *(const LAS u32x4*)(lds + rr * 512 + c8 * 16);
            sum[0] += bf_lo(w.x); sum[1] += bf_hi(w.x); sum[2] += bf_lo(w.y); sum[3] += bf_hi(w.y); sum[4] += bf_lo(w.z); sum[5] += bf_hi(w.z); sum[6] += bf_lo(w.w); sum[7] += bf_hi(w.w);
        }
#pragma unroll
        for (int i = 0; i < 8; ++i) {
            const int tt = tt0 + i, t = t0 + tt;
            const int lo = max(t - hw, 0), hi = min(t + hw, L);
            const float inv = 1.0f / (float)(hi - lo);
            const u32x4 cw = *(const LAS u32x4*)(lds + (tt + 8) * 512 + c8 * 16);
            const u32x4 sw = sgv[i];
            float y[8];
            y[0] = (sum[0] * inv - bf_lo(cw.x)) * sc0[0] * bf_lo(sw.x); y[1] = (sum[1] * inv - bf_hi(cw.x)) * sc0[1] * bf_hi(sw.x);
            y[2] = (sum[2] * inv - bf_lo(cw.y)) * sc0[2] * bf_lo(sw.y); y[3] = (sum[3] * inv - bf_hi(cw.y)) * sc0[3] * bf_hi(sw.y);
            y[4] = (sum[4] * inv - bf_lo(cw.z)) * sc1[0] * bf_lo(sw.z); y[5] = (sum[5] * inv - bf_hi(cw.z)) * sc1[1] * bf_hi(sw.z);
            y[6] = (sum[6] * inv - bf_lo(cw.w)) * sc1[2] * bf_lo(sw.w); y[7] = (sum[7] * inv - bf_hi(cw.w)) * sc1[3] * bf_hi(sw.w);
            *(u32x4*)(Y + (size_t)(row0 + tt) * 2048 + cg) = (u32x4){cvt_pk_bf16(y[0], y[1]), cvt_pk_bf16(y[2], y[3]), cvt_pk_bf16(y[4], y[5]), cvt_pk_bf16(y[6], y[7])};
            if (i < 7) {
                const u32x4 a = *(const LAS u32x4*)(lds + (tt + 8 + hw) * 512 + c8 * 16), b = *(const LAS u32x4*)(lds + (tt + 8 - hw) * 512 + c8 * 16);
                sum[0] += bf_lo(a.x) - bf_lo(b.x); sum[1] += bf_hi(a.x) - bf_hi(b.x); sum[2] += bf_lo(a.y) - bf_lo(b.y); sum[3] += bf_hi(a.y) - bf_hi(b.y);
                sum[4] += bf_lo(a.z) - bf_lo(b.z); sum[5] += bf_hi(a.z) - bf_hi(b.z); sum[6] += bf_lo(a.w) - bf_lo(b.w); sum[7] += bf_hi(a.w) - bf_hi(b.w);
            }
        }
        __syncthreads();
    }
#undef POOL_GEOM
#undef POOL_LOADZ
}

constexpr int AT_KB = 128 * 144, AT_VB = 64 * 264, AT_BUF = AT_KB + AT_VB;
__device__ __forceinline__ void attn_phase(int wv, int vcu, bool rev, LAS unsigned char* lds, const bf16_t* Q, const bf16_t* Kl, const bf16_t* VT, const bf16_t* KC, const bf16_t* VCT, const bf16_t* SGA, const float* sink, bf16_t* Y) {
    const int tid = get_tid(wv), wave = __builtin_amdgcn_readfirstlane(tid >> 6), lane = tid & 63, l32 = lane & 31, h = lane >> 5;
    const int gq = wave >> 1, qhalf = wave & 1;
    const float NEG = -1.0e30f;
    for (int uu = vcu; uu < NB * 4 * 16; uu += gridDim.x) {
        const int u = unit_remap(uu, NB * 4 * 16, rev);
        const int kvh = u & 3, n = (u >> 2) & 15, b = u >> 6, start = n * 128, head = kvh * 4 + gq;
        const int qrow0 = b * SEQ + start + qhalf * 64;
        bf16x8 qf[2][4];
        unsigned lrow_off = (unsigned)(l32 * 1024 + h * 8) * 2u;
        asm volatile("" : "+v"(lrow_off));
#pragma unroll
        for (int nq = 0; nq < 2; ++nq) {
            const char* qb = (const char*)(Q + (size_t)(qrow0 + nq * 32) * 1024 + head * 64);
#pragma unroll
            for (int ks = 0; ks < 4; ++ks) qf[nq][ks] = *(const bf16x8*)(qb + lrow_off + ks * 32);
        }
        const int has0 = n > 0, has2 = n < 15, nsteps = 3 + has0 + has2;
        f32x16 O[2][2];
#pragma unroll
        for (int a = 0; a < 2; ++a)
#pragma unroll
            for (int c = 0; c < 2; ++c)
#pragma unroll
                for (int i = 0; i < 16; ++i) O[a][c][i] = 0.f;
        float m_run[2] = {NEG, NEG}, l_run[2] = {0.f, 0.f};
        u32x4 stg[2];
#define AT_PTRS(s) const int _s = (s); const bf16_t* kp; const bf16_t* vp; int vst; \
        if (_s < 2) { kp = KC + (size_t)(b * LC + _s * 128) * 256 + kvh * 64; vp = VCT + (size_t)((b * 4 + kvh) * 64) * LC + _s * 128; vst = LC; } \
        else { const int li = _s - 2 + (has0 ? 0 : 1); kp = Kl + (size_t)(b * SEQ + start - 128 + li * 128) * 256 + kvh * 64; vp = VT + (size_t)((b * 4 + kvh) * 64) * SEQ + (start - 128 + li * 128); vst = SEQ; }
#define AT_LOADK(s) do { AT_PTRS(s) (void)vp; (void)vst; \
        _Pragma("unroll") for (int it = 0; it < 2; ++it) { const int idx = tid + 512 * it; stg[it] = *(const u32x4*)((const char*)kp + (unsigned)((idx >> 3) * 512 + (idx & 7) * 16)); } } while (0)
#define AT_LOADV(s) do { AT_PTRS(s) (void)kp; \
        _Pragma("unroll") for (int it = 0; it < 2; ++it) { const int idx = tid + 512 * it; stg[it] = *(const u32x4*)((const char*)vp + (unsigned)((idx >> 4) * vst * 2 + (idx & 15) * 16)); } } while (0)
#define AT_STOREK(buf) do { LAS unsigned char* _kb = lds + (buf) * AT_BUF; \
        _Pragma("unroll") for (int it = 0; it < 2; ++it) { const int idx = tid + 512 * it; *(LAS u32x4*)(_kb + (idx >> 3) * 144 + (idx & 7) * 16) = stg[it]; } } while (0)
#define AT_STOREV(buf) do { LAS unsigned char* _vb = lds + (buf) * AT_BUF + AT_KB; \
        _Pragma("unroll") for (int it = 0; it < 2; ++it) { const int idx = tid + 512 * it; \
            *(LAS u32x2*)(_vb + (idx >> 4) * 264 + (idx & 15) * 16) = (u32x2){stg[it].x, stg[it].y}; \
            *(LAS u32x2*)(_vb + (idx >> 4) * 264 + (idx & 15) * 16 + 8) = (u32x2){stg[it].z, stg[it].w}; } } while (0)
        AT_LOADK(0); AT_STOREK(0); AT_LOADV(0); AT_STOREV(0);
        __syncthreads();
        for (int s = 0; s < nsteps; ++s) {
            const bool more = s + 1 < nsteps;
            if (more) AT_LOADK(s + 1);
            const int li = (s < 2) ? 1 : (s - 2 + (has0 ? 0 : 1));
            LAS unsigned char* kb = lds + (s & 1) * AT_BUF; LAS unsigned char* vb = kb + AT_KB;
            const bool dead01 = (li == 0 && qhalf == 1), dead23 = (li == 2 && qhalf == 0);
#define AT_DEAD(it) (((it) >> 2) ? dead23 : dead01)
#define AT_ISSUE(it, SD) do { if (!AT_DEAD(it)) { const int blk_ = (it) >> 1, nq_ = (it) & 1; \
                _Pragma("unroll") for (int i = 0; i < 16; ++i) SD[i] = 0.f; \
                _Pragma("unroll") for (int ks = 0; ks < 4; ++ks) { \
                    const bf16x8 kf = *(const LAS bf16x8*)(kb + (blk_ * 32 + l32) * 144 + (ks * 16 + h * 8) * 2); \
                    SD = __builtin_amdgcn_mfma_f32_32x32x16_bf16(kf, qf[nq_][ks], SD, 0, 0, 0); } } } while (0)
#define AT_ITEM(it, SD) do { if (!AT_DEAD(it)) { const int blk_ = (it) >> 1, nq_ = (it) & 1; \
                if (li != 1) { const int qi = qhalf * 64 + nq_ * 32 + l32; \
                    _Pragma("unroll") for (int i = 0; i < 16; ++i) { const int kk = blk_ * 32 + 8 * (i >> 2) + 4 * h + (i & 3); const bool keep = (li == 0) ? (kk >= qi) : (kk <= qi); if (!keep) SD[i] = NEG; } } \
                float mx = NEG; \
                _Pragma("unroll") for (int i = 0; i < 16; i += 2) mx = fmaxf(fmaxf(mx, SD[i]), SD[i + 1]); \
                mx = fmaxf(mx, shx(mx, 32, lane)); \
                if (__builtin_amdgcn_ballot_w64(mx > m_run[nq_] + 8.0f) != 0ull) { \
                    const float mnew = fmaxf(m_run[nq_], mx), alpha = fexp2((m_run[nq_] - mnew) * L2E); \
                    m_run[nq_] = mnew; l_run[nq_] *= alpha; \
                    _Pragma("unroll") for (int i = 0; i < 16; ++i) { O[0][nq_][i] *= alpha; O[1][nq_][i] *= alpha; } } \
                const f32x2 ms2 = (f32x2){m_run[nq_] * L2E, m_run[nq_] * L2E}; f32x2 ls2 = (f32x2){0.f, 0.f}; unsigned pw[8]; \
                _Pragma("unroll") for (int i = 0; i < 16; i += 2) { \
                    const f32x2 t2 = (f32x2){SD[i], SD[i + 1]} * L2E - ms2; const f32x2 p2 = (f32x2){fexp2(t2[0]), fexp2(t2[1])}; \
                    ls2 += p2; pw[i >> 1] = cvt_pk_bf16(p2[0], p2[1]); } \
                l_run[nq_] += ls2[0] + ls2[1]; \
                _Pragma("unroll") for (int sl = 0; sl < 2; ++sl) { \
                    const bf16x8 pf = __builtin_bit_cast(bf16x8, ((u32x4){pw[4 * sl], pw[4 * sl + 1], pw[4 * sl + 2], pw[4 * sl + 3]})); \
                    const int kbase = blk_ * 32 + sl * 16 + 4 * h; \
                    _Pragma("unroll") for (int dm = 0; dm < 2; ++dm) { \
                        LAS unsigned char* vp = vb + (dm * 32 + l32) * 264 + kbase * 2; \
                        const u32x2 v0 = *(const LAS u32x2*)vp, v1 = *(const LAS u32x2*)(vp + 16); \
                        const bf16x8 vf = __builtin_bit_cast(bf16x8, ((u32x4){v0.x, v0.y, v1.x, v1.y})); \
                        O[dm][nq_] = __builtin_amdgcn_mfma_f32_32x32x16_bf16(vf, pf, O[dm][nq_], 0, 0, 0); } } } } while (0)
            {
                f32x16 SA, SB;
                AT_ISSUE(0, SA);
                AT_ISSUE(1, SB); AT_ITEM(0, SA);
                AT_ISSUE(2, SA); AT_ITEM(1, SB);
                AT_ISSUE(3, SB); AT_ITEM(2, SA);
                AT_ISSUE(4, SA); AT_ITEM(3, SB);
                if (more) { AT_STOREK((s + 1) & 1); AT_LOADV(s + 1); }
                AT_ISSUE(5, SB); AT_ITEM(4, SA);
                AT_ISSUE(6, SA); AT_ITEM(5, SB);
                AT_ISSUE(7, SB); AT_ITEM(6, SA);
                AT_ITEM(7, SB);
                if (more) { AT_STOREV((s + 1) & 1); }
            }
#undef AT_DEAD
#undef AT_ISSUE
#undef AT_ITEM
            __syncthreads();
        }
#undef AT_PTRS
#undef AT_LOADK
#undef AT_LOADV
#undef AT_STOREK
#undef AT_STOREV
        const float sk = sink[head];
#pragma unroll
        for (int nq = 0; nq < 2; ++nq) {
            const float lt = l_run[nq] + shx(l_run[nq], 32, lane) + fexp2((sk - m_run[nq]) * L2E);
            const float inv = 1.0f / lt;
            const size_t rob = ((size_t)(qrow0 + nq * 32) * 1024 + head * 64) * 2;
            unsigned lo = (unsigned)(l32 * 1024 + 4 * h) * 2u; asm volatile("" : "+v"(lo));
#pragma unroll
            for (int dm = 0; dm < 2; ++dm)
#pragma unroll
                for (int i4 = 0; i4 < 4; ++i4) {
                    const int d = dm * 32 + 8 * i4;
                    const u32x2 g = *(const u32x2*)((const char*)SGA + rob + lo + d * 2);
                    const float o0 = O[dm][nq][4 * i4 + 0] * inv * bf_lo(g.x), o1 = O[dm][nq][4 * i4 + 1] * inv * bf_hi(g.x), o2 = O[dm][nq][4 * i4 + 2] * inv * bf_lo(g.y), o3 = O[dm][nq][4 * i4 + 3] * inv * bf_hi(g.y);
                    *(u32x2*)((char*)Y + rob + lo + d * 2) = (u32x2){cvt_pk_bf16(o0, o1), cvt_pk_bf16(o2, o3)};
                }
        }
    }
}


#define XB_TMO      128
#define XB_XCNT(j)  (256  + 64 * (j))
#define XB_XSUB(j)  (1280 + 64 * (j))
#define XB_XGEN(j)  (2304 + 64 * (j))
#define XB_TOP      3328
#define XB_TOPGEN   3392
#define XCD_BAR_WORDS 3456
#define XB_SPIN_CAP (1u << 20)
__device__ __forceinline__ unsigned xb_ld(unsigned* p)              { return __hip_atomic_load(p, __ATOMIC_RELAXED, __HIP_MEMORY_SCOPE_AGENT); }
__device__ __forceinline__ unsigned xb_add(unsigned* p, unsigned v) { return __hip_atomic_fetch_add(p, v, __ATOMIC_RELAXED, __HIP_MEMORY_SCOPE_AGENT); }
__device__ __forceinline__ unsigned xb_xcc_id() { return (unsigned)__builtin_amdgcn_s_getreg((3 << 11) | 20) & 0xFu; }
#define XB_SPIN(cond, bar) do { unsigned _sp = 0; while (cond) { __builtin_amdgcn_s_sleep(1); \
    if ((++_sp & 255u) == 0u) { if (xb_ld(&(bar)[XB_TMO])) break; if (_sp > XB_SPIN_CAP) { atomicAdd(&(bar)[XB_TMO], 1u); break; } } } } while (0)
struct XcdBarrier { unsigned* bar; unsigned x; volatile LAS unsigned* st; };
__device__ __forceinline__ void xcd_barrier_complete(unsigned* bar, unsigned x, unsigned& nloc, unsigned& nx) {
    const unsigned G = gridDim.x;
    unsigned sum, cnt, mine, sp = 0u;
    for (;;) {
        sum = 0u; cnt = 0u; mine = 0u;
#pragma unroll
        for (unsigned j = 0; j < 16; ++j) { const unsigned c = xb_ld(&bar[XB_XCNT(j)]); sum += c; cnt += (c > 0u) ? 1u : 0u; mine = (j == x) ? c : mine; }
        if (sum == G) break;
        __builtin_amdgcn_s_sleep(1);
        if ((++sp & 255u) == 0u) { if (xb_ld(&bar[XB_TMO])) break; if (sp > XB_SPIN_CAP) { atomicAdd(&bar[XB_TMO], 1u); break; } }
    }
    nloc = mine > 0u ? mine : 1u; nx = cnt > 0u ? cnt : 1u;
}
__device__ __forceinline__ void xcd_barrier(const XcdBarrier& b, int tid) {
    asm volatile("s_waitcnt vmcnt(0)" ::: "memory");
    __syncthreads();
    if (tid == 0) {
        unsigned* bar = b.bar;
        __builtin_amdgcn_s_waitcnt(0);
        unsigned nloc = b.st[0], nx = b.st[1];
        if (nloc == 0u) { xcd_barrier_complete(bar, b.x, nloc, nx); b.st[0] = nloc; b.st[1] = nx; }
        const unsigned old = xb_add(&bar[XB_XSUB(b.x)], 1u);
        const unsigned gen = old / nloc;
        if (old + 1u == (gen + 1u) * nloc) {
            __builtin_amdgcn_fence(__ATOMIC_RELEASE, "agent");
            asm volatile("s_waitcnt vmcnt(0)" ::: "memory");
            const unsigned og = xb_add(&bar[XB_TOP], 1u);
            const unsigned tg = og / nx;
            if (og + 1u == (tg + 1u) * nx) xb_add(&bar[XB_TOPGEN], 1u);
            else XB_SPIN(xb_ld(&bar[XB_TOPGEN]) == tg, bar);
            __builtin_amdgcn_fence(__ATOMIC_ACQUIRE, "agent");
            xb_add(&bar[XB_XGEN(b.x)], 1u);
            asm volatile("s_waitcnt vmcnt(0)" ::: "memory");
        } else {
            XB_SPIN(xb_ld(&bar[XB_XGEN(b.x)]) == gen, bar);
            __builtin_amdgcn_fence(__ATOMIC_ACQUIRE, "agent");
            asm volatile("s_waitcnt vmcnt(0)" ::: "memory");
        }
    }
    __syncthreads();
}

constexpr int N_PHASES = 20;
__global__ void __launch_bounds__(512, 2) mega_fwd(Params P) {
    extern __shared__ __attribute__((aligned(16))) unsigned char lds_raw[];
    LAS unsigned char* lds = (LAS unsigned char*)lds_raw;
    cg::grid_group grid = cg::this_grid();
    unsigned char* const ws = P.ws;
    const int G = gridDim.x, bid = blockIdx.x;
    const int wv = __builtin_amdgcn_readfirstlane((int)threadIdx.x >> 6);
    XcdBarrier xb; xb.bar = (unsigned*)(ws + WS_CTL); xb.x = xb_xcc_id(); xb.st = (volatile LAS unsigned*)(lds + LDS_BYTES - 64);
    { const int t0 = get_tid(wv); if (t0 == 0) { xb.st[0] = 0u; xb.st[1] = 0u; xb.st[2] = xb_add(&xb.bar[XB_XCNT(xb.x)], 1u); xb.st[3] = (unsigned)bid; } __syncthreads(); }
#define IN(k) (P.ph_lo <= (k) && (k) < P.ph_hi)
#ifndef DUPMASK
#define DUPMASK 0
#endif
#define REP(k) for (int rep_ = 0; rep_ < (((DUPMASK) >> (k)) & 1) + 1; ++rep_)
#define SYNC(k) do { xcd_barrier(xb, get_tid(wv)); } while (0)
#define SYNC_CG(k) do { grid.sync(); } while (0)
#define WSP(T, off) ((T*)(ws + (off)))
#define MOD(layer) (WSP(float, WS_MOD) + (layer) * MODSZ)
#define AQ   (WSP(bf16_t, WS_R1))
#define ASG  (WSP(bf16_t, WS_R1) + (size_t)ML * 1024)
#define AK   (WSP(bf16_t, WS_R2))
#define AVT  (WSP(bf16_t, WS_R2) + (size_t)ML * 256)
#define AKC  (WSP(bf16_t, WS_R2) + (size_t)ML * 512)
#define AVCT (WSP(bf16_t, WS_R2) + (size_t)ML * 512 + (size_t)MC * 256)
#define RUN_GEMM(MODE, gm, E, oc, rv) do { pg8::StaticOrder S_; S_.init((gm).M, (gm).N, G, (oc), (rv)); pg8::gemm_phase<Epi<MODE>>(wv, lds, (gm), S_, (E)); } while (0)

    prep_phase(wv, lds, P, 0);
    SYNC(0);
    int vcu = bid;
    {
        const int t0 = get_tid(wv);
        if (t0 == 0) {
            unsigned nx = 0u, ok = 1u;
#pragma unroll
            for (unsigned j = 0; j < 16; ++j) { const unsigned c = xb_ld(&xb.bar[XB_XCNT(j)]); if (j < 8u) { if (c * 8u != (unsigned)G) ok = 0u; nx += (c > 0u); } else if (c != 0u) ok = 0u; }
            if (ok && nx == 8u && xb.x < 8u && xb.st[2] * 8u < (unsigned)G) xb.st[3] = xb.st[2] * 8u + xb.x;
        }
        __syncthreads();
        vcu = __builtin_amdgcn_readfirstlane((int)xb.st[3]);
    }
#define XSB ((bf16_t*)P.out)
#define R0B WSP(bf16_t, WS_R0)
#define R1B WSP(bf16_t, WS_R1)
#define R2B WSP(bf16_t, WS_R2)
#define SUMSQ(i) (WSP(float, WS_SUMSQ) + (size_t)(i) * MT)
#define BIAS1 (WSP(float, WS_BIAS))
#define BIAS2 (WSP(float, WS_BIAS) + 64 * 4096)
#define BIAS3 (WSP(float, WS_BIAS) + 64 * (4096 + 2560))
    { shift16_phase(wv, WSP(const float, WS_MOD), WSP(bf16_t, WS_SHIFT16)); norm_phase(wv, vcu, false, P.x, P.ctx, MT, P.norm_g, MOD(0), R0B); prep_phase(wv, lds, P, 1); }
    SYNC_CG(1);
    REP(3) if (IN(3)) {
        pg8::Gemm gm{R0B, WSP(const bf16_t, WS_GIN0), MT, 6144, 1024, 1024, 1024, 0, 0u};
        Epi<EPI_GMLP1> E{}; E.o0 = R1B; E.o1 = R2B; E.stats = WSP(float, WS_STATS); RUN_GEMM(EPI_GMLP1, gm, E, vcu, 1);
    }
    SYNC(3);
    REP(4) if (IN(4)) spatial_phase(wv, vcu, false, lds, MT / 128, R1B, R2B, WSP(const float, WS_STATS), WSP(const bf16_t, WS_GWS), P.gmlp_vn_g, P.gmlp_vn_b, P.gmlp_b_s, R0B);
    {
        pg8::Gemm gm{WSP(const bf16_t, WS_PGRPT), WSP(const bf16_t, WS_PINNT), 2048, 1024, 512, 512, 2048, 1, 1024u};
        Epi<EPI_BF16> E{}; E.o0 = WSP(bf16_t, WS_PINT); E.ldc = 1024; RUN_GEMM(EPI_BF16, gm, E, vcu, 0);
    }
    SYNC(4);
    if (IN(5)) {
        pg8::Gemm gm{R0B, WSP(const bf16_t, WS_GOUT0), MT, 1024, 2048, 2048, 2048, 0, 0u};
        Epi<EPI_RES> E{}; E.gate = MOD(0) + 2048; E.xil = P.x; E.xic = P.ctx; E.xmode = 0; E.xb_in = XSB; E.xb_out = XSB;
        E.hout = R1B; E.sumsq_out = SUMSQ(0); E.gnext = P.norm_g + DM; E.modnext = MOD(1); RUN_GEMM(EPI_RES, gm, E, vcu, 1);
        for (int l = 0; l < 3; ++l) {
            const bf16_t* bt = l == 0 ? WSP(const bf16_t, WS_PINT) : (l == 1 ? WSP(const bf16_t, WS_AIN) : WSP(const bf16_t, WS_GIN1));
            const int nn = l == 0 ? 4096 : (l == 1 ? 2560 : 6144);
            pg8::Gemm gb{WSP(const bf16_t, WS_SHIFT16) + (size_t)l * 256 * 1024, bt, 256, nn, 1024, 1024, 1024, 0, 0u};
            Epi<EPI_F32> Eb{}; Eb.o0 = (bf16_t*)(l == 0 ? BIAS1 : (l == 1 ? BIAS2 : BIAS3)); Eb.ldc = nn; RUN_GEMM(EPI_F32, gb, Eb, (vcu + (l == 0 ? 128 : (l == 1 ? 112 : 102))) % G, 0);
        }
    }
    SYNC(5);
    REP(7) if (IN(7)) {
        pg8::Gemm gm{R1B, WSP(const bf16_t, WS_PINT), MT, 4096, 1024, 1024, 1024, 0, 0u};
        Epi<EPI_POOL1> E{}; E.o0 = R0B; E.o1 = R2B; E.sumsq_in = SUMSQ(0); E.bias = BIAS1; E.ldc = 4096; RUN_GEMM(EPI_POOL1, gm, E, vcu, 1);
    }
    SYNC(7);
    REP(8) if (IN(8)) pool_phase(wv, vcu, false, lds, R0B, R2B, P.pool_scale, R1B);
    SYNC(8);
    if (IN(9)) {
        pg8::Gemm gm{R1B, WSP(const bf16_t, WS_POUT), MT, 1024, 2048, 2048, 2048, 0, 0u};
        Epi<EPI_RES> E{}; E.gate = MOD(1) + 2048; E.xmode = 1; E.xb_in = XSB; E.xb_out = XSB;
        E.hout = R0B; E.sumsq_out = SUMSQ(1); E.gnext = P.norm_g + 2 * DM; E.modnext = MOD(2); RUN_GEMM(EPI_RES, gm, E, vcu, 1);
    }
    SYNC(9);
    REP(11) if (IN(11)) {
        pg8::Gemm gm{R0B, WSP(const bf16_t, WS_AIN), ML, 2560, 1024, 1024, 1024, 0, 0u};
        Epi<EPI_ATTN1> E{}; E.o0 = AQ; E.o1 = AK; E.o2 = AVT; E.o3 = ASG; E.rc = WSP(const float, WS_ROPEC); E.rs = WSP(const float, WS_ROPES);
        E.sumsq_in = SUMSQ(1); E.bias = BIAS2; E.ldc = 2560; RUN_GEMM(EPI_ATTN1, gm, E, vcu, 1);
    }
    REP(12) if (IN(12)) {
        pg8::Gemm gm{R0B + (size_t)ML * 1024, WSP(const bf16_t, WS_AIN) + (size_t)1024 * 1024, MC, 512, 1024, 1024, 1024, 0, 0u};
        Epi<EPI_ATTNC> E{}; E.o0 = AKC; E.o1 = AVCT; E.sumsq_in = SUMSQ(1); E.bias = BIAS2 + 1024; E.ldc = 2560; E.rowoff = ML; E.ctxonly = 1; RUN_GEMM(EPI_ATTNC, gm, E, (vcu + G / 2) % G, 0);
    }
    SYNC(12);
    REP(13) if (IN(13)) attn_phase(wv, vcu, false, lds, AQ, AK, AVT, AKC, AVCT, ASG, P.attn_sink, R0B);
    SYNC(13);
    if (IN(14)) {
        pg8::Gemm gm{R0B, WSP(const bf16_t, WS_AOUT), ML, 1024, 1024, 1024, 1024, 0, 0u};
        Epi<EPI_RES> E{}; E.gate = MOD(2) + 2048; E.xmode = 1; E.xb_in = XSB; E.xb_out = XSB;
        E.hout = R1B; E.sumsq_out = SUMSQ(2); E.gnext = P.norm_g + 3 * DM; E.modnext = MOD(3); RUN_GEMM(EPI_RES, gm, E, vcu, 1);
    }
    SYNC(14);
    REP(16) if (IN(16)) {
        pg8::Gemm gm{R1B, WSP(const bf16_t, WS_GIN1), ML, 6144, 1024, 1024, 1024, 0, 0u};
        Epi<EPI_GMLP1> E{}; E.o0 = R0B; E.o1 = R2B; E.stats = WSP(float, WS_STATS); E.sumsq_in = SUMSQ(2); E.bias = BIAS3; E.ldc = 6144; RUN_GEMM(EPI_GMLP1, gm, E, vcu, 1);
    }
    SYNC(16);
    REP(17) if (IN(17)) spatial_phase(wv, vcu, false, lds, ML / 128, R0B, R2B, WSP(const float, WS_STATS), WSP(const bf16_t, WS_GWS) + (size_t)8 * 16384, P.gmlp_vn_g + 2048, P.gmlp_vn_b + 2048, P.gmlp_b_s + 1024, R1B);
    SYNC(17);
    if (IN(18)) {
        pg8::Gemm gm{R1B, WSP(const bf16_t, WS_GOUT1), ML, 1024, 2048, 2048, 2048, 0, 0u};
        Epi<EPI_RES> E{}; E.gate = MOD(3) + 2048; E.xmode = 1; E.xb_in = XSB; E.xb_out = R0B; RUN_GEMM(EPI_RES, gm, E, vcu, 1);
    }
    SYNC(18);
    REP(19) if (IN(19)) final_phase(wv, vcu, false, R0B, P.out, P.final_g);
}

extern "C" void kernel_launch(void* const* d_in, const int* in_sizes, int n_in, void* d_out, int out_size, void* d_ws, size_t ws_size, hipStream_t stream) {
    static int grid = 0;
    if (grid == 0) {
        if (ws_size < WS_END) { fprintf(stderr, "kernel_launch: workspace too small (%zu < %zu)\n", ws_size, (size_t)WS_END); grid = -1; return; }
        int dev = 0, cus = 0, per_cu = 0;
        hipGetDevice(&dev);
        hipDeviceGetAttribute(&cus, hipDeviceAttributeMultiprocessorCount, dev);
        if (hipFuncSetAttribute((const void*)mega_fwd, hipFuncAttributeMaxDynamicSharedMemorySize, LDS_BYTES) != hipSuccess) { fprintf(stderr, "kernel_launch: hipFuncSetAttribute failed\n"); grid = -1; return; }
        if (hipOccupancyMaxActiveBlocksPerMultiprocessor(&per_cu, (const void*)mega_fwd, 512, LDS_BYTES) != hipSuccess || per_cu < 1) { fprintf(stderr, "kernel_launch: occupancy query gave %d\n", per_cu); per_cu = 1; }
        (void)hipGetLastError();
        grid = cus * per_cu;
        fprintf(stderr, "kernel_launch: grid %d (cus %d x %d)\n", grid, cus, per_cu);
    }
    if (grid < 0) return;
    if (hipMemsetAsync((char*)d_ws + WS_CTL, 0, 16384, stream) != hipSuccess) { fprintf(stderr, "kernel_launch: memset failed\n"); return; }
    Params p{};
    p.x = (const float*)d_in[0]; p.c = (const float*)d_in[1]; p.ctx = (const float*)d_in[2]; p.c_ctx = (const float*)d_in[3];
    p.ada_w = (const float*)d_in[4]; p.ada_b = (const float*)d_in[5]; p.norm_g = (const float*)d_in[6]; p.final_g = (const float*)d_in[7];
    p.gmlp_w_in = (const float*)d_in[8]; p.gmlp_vn_g = (const float*)d_in[9]; p.gmlp_vn_b = (const float*)d_in[10]; p.gmlp_w_s = (const float*)d_in[11];
    p.gmlp_b_s = (const float*)d_in[12]; p.gmlp_w_out = (const float*)d_in[13];
    p.pool_w_in = (const float*)d_in[14]; p.pool_w_grp = (const float*)d_in[15]; p.pool_scale = (const float*)d_in[16]; p.pool_w_out = (const float*)d_in[17];
    p.attn_w_in = (const float*)d_in[18]; p.attn_sink = (const float*)d_in[19]; p.attn_w_out = (const float*)d_in[20];
    p.out = (float*)d_out; p.ws = (unsigned char*)d_ws; p.ph_lo = 0; p.ph_hi = N_PHASES;
    void* args[] = {&p};
    hipError_t e = hipLaunchCooperativeKernel((const void*)mega_fwd, dim3(grid), dim3(512), args, LDS_BYTES, stream);
    if (e != hipSuccess) fprintf(stderr, "kernel_launch: cooperative launch failed: %s (grid %d)\n", hipGetErrorString(e), grid);
}
```

```cpp
#include <hip/hip_runtime.h>
#include <hip/hip_cooperative_groups.h>
#include <cstdio>
namespace cg = cooperative_groups;

#define LAS __attribute__((address_space(3)))
typedef unsigned short bf16_t;
typedef short bf16x8 __attribute__((ext_vector_type(8)));
typedef short s16x4 __attribute__((ext_vector_type(4)));
typedef float f32x2 __attribute__((ext_vector_type(2)));
typedef float f32x4 __attribute__((ext_vector_type(4)));
typedef float f32x16 __attribute__((ext_vector_type(16)));
typedef unsigned u32x2 __attribute__((ext_vector_type(2)));
typedef unsigned u32x4 __attribute__((ext_vector_type(4)));

constexpr int DM = 1024, NB = 32, SEQ = 2048, LC = 256;
constexpr int ML = NB * SEQ, MC = NB * LC, MT = ML + MC;
constexpr int MODSZ = 33 * 3072;
constexpr float L2E = 1.4426950408889634f;

constexpr size_t MiB = 1u << 20;
constexpr size_t WS_MOD = 0;
constexpr size_t WS_ROPEC = 2 * MiB;
constexpr size_t WS_ROPES = 2 * MiB + 512 * 1024;
constexpr size_t WS_CTL = 3 * MiB;
constexpr size_t WS_GIN0 = 4 * MiB;
constexpr size_t WS_GIN1 = 16 * MiB;
constexpr size_t WS_GOUT0 = 28 * MiB;
constexpr size_t WS_GOUT1 = 32 * MiB;
constexpr size_t WS_GWS = 36 * MiB;
constexpr size_t WS_PINNT = 37 * MiB;
constexpr size_t WS_PINT = 41 * MiB;
constexpr size_t WS_PGRPT = 49 * MiB;
constexpr size_t WS_POUT = 51 * MiB;
constexpr size_t WS_AIN = 55 * MiB;
constexpr size_t WS_AOUT = 60 * MiB;
constexpr size_t WS_XC = 64 * MiB;
constexpr size_t WS_STATS = 96 * MiB;
constexpr size_t WS_R0 = 116 * MiB;
constexpr size_t WS_R1 = 404 * MiB;
constexpr size_t WS_R2 = 692 * MiB;
constexpr size_t WS_BIAS = 980 * MiB;
constexpr size_t WS_SHIFT16 = 984 * MiB;
constexpr size_t WS_SUMSQ = 3 * MiB + 65536;
constexpr size_t WS_END = 986 * MiB;

constexpr int LDS_BYTES = 147456;

typedef __bf16 bf16x2_t __attribute__((ext_vector_type(2)));
__device__ __forceinline__ unsigned cvt_pk_bf16(float lo, float hi) { const f32x2 v = {lo, hi}; const bf16x2_t r = __builtin_convertvector(v, bf16x2_t); return __builtin_bit_cast(unsigned, r); }
__device__ __forceinline__ float bf_lo(unsigned w) { return __uint_as_float(w << 16); }
__device__ __forceinline__ float bf_hi(unsigned w) { return __uint_as_float(w & 0xffff0000u); }
__device__ __forceinline__ float fexp2(float x) { return __builtin_amdgcn_exp2f(x); }
__device__ __forceinline__ float frcp(float x) { return __builtin_amdgcn_rcpf(x); }
__device__ __forceinline__ float silu_f(float x) { return x * frcp(1.0f + fexp2(-L2E * x)); }
__device__ __forceinline__ float gelu_f(float x) { const float t = x * (1.0f + 0.044715f * x * x); return x * frcp(1.0f + fexp2(-2.302208198f * t)); }
__device__ __forceinline__ f32x2 ugate2(f32x2 u, f32x2 g) {
    const f32x2 a = u * (u * u * (-0.1029432397f) + (-2.302208198f));
    const f32x2 b = g * (-L2E);
    const f32x2 e1 = (f32x2){fexp2(a[0]), fexp2(a[1])}, e2 = (f32x2){fexp2(b[0]), fexp2(b[1])};
    const f32x2 d1 = e1 + 1.0f, d = d1 + e2 * d1;
    return (u * g) * (f32x2){frcp(d[0]), frcp(d[1])};
}
__device__ __forceinline__ f32x2 gelu2(f32x2 u) {
    const f32x2 a = u * (u * u * (-0.1029432397f) + (-2.302208198f));
    const f32x2 d = (f32x2){fexp2(a[0]), fexp2(a[1])} + 1.0f;
    return u * (f32x2){frcp(d[0]), frcp(d[1])};
}
__device__ __forceinline__ int get_tid(int wv) { int t = wv * 64 + (int)__builtin_amdgcn_mbcnt_hi(~0u, __builtin_amdgcn_mbcnt_lo(~0u, 0u)); asm volatile("" : "+v"(t)); return t; }
__device__ __forceinline__ int unit_remap(int L, int n, bool rev) { if (rev) L = n - 1 - L; return (L & 7) * (n >> 3) + (L >> 3); }
__device__ __forceinline__ float shx(float v, int mask, int lane) { return __int_as_float(__builtin_amdgcn_ds_bpermute((lane ^ mask) << 2, __float_as_int(v))); }
__device__ __forceinline__ float wave_sum(float v, int lane) {
#pragma unroll
    for (int o = 1; o < 64; o <<= 1) v += shx(v, o, lane);
    return v;
}

namespace pg8 {
constexpr int BM = 256, BK = 64, HALF = 128, HTB = HALF * BK * 2, STAGE_BYTES = 8 * HTB, NXCD = 8, WGM = 8;
__device__ __forceinline__ int lds_byte(int r, int c) { const int st = (r >> 4) * 2 + (c >> 5), rr = r & 15, cc = c & 31, ob = rr * 64 + cc * 2; return st * 1024 + (ob ^ (((ob >> 9) & 1) << 5)); }
__device__ __forceinline__ void stage_rc(int b, int& R, int& C) { const int st = b / 1024, sb = b % 1024, swz = sb ^ (((sb >> 9) & 1) << 5); R = (st >> 1) * 16 + swz / 64; C = (st & 1) * 32 + (swz % 64) / 2; }
__device__ __forceinline__ int perm32(int rho) { const int n = rho >> 4, i = rho & 15; return 8 * (i >> 2) + 4 * n + (i & 3); }
struct Unit { int pm, pn; };
struct Gemm { const bf16_t* A; const bf16_t* Bt; int M, N, K, lda, ldb; int bsh; unsigned bmul; };
struct StaticOrder {
    int nM, nN, nwg, G, c, rev;
    __device__ void init(int M, int N, int G_, int c_, int rev_) { nM = M / BM; nN = N / BM; nwg = nM * nN; G = G_; c = c_; rev = rev_; }
    __device__ bool next(int i, Unit& u) const {
        const long L = (long)i * G + c; if (L >= nwg) return false;
        int wgid = rev ? (nwg - 1 - (int)L) : (int)L; { const int q = nwg / NXCD, r = nwg % NXCD, xcd = wgid % NXCD, off = wgid / NXCD; wgid = (xcd < r ? xcd * (q + 1) : r * (q + 1) + (xcd - r) * q) + off; }
        const int nig = WGM * nN, gid = wgid / nig, fm = gid * WGM, gsz = (nM - fm) < WGM ? (nM - fm) : WGM;
        u.pm = fm + ((wgid % nig) % gsz); u.pn = (wgid % nig) / gsz; return true;
    }
};

template <class Epi>
__device__ __forceinline__ void gemm_phase(int wv, LAS unsigned char* lds, const Gemm g, const StaticOrder& S, const Epi& E) {
    const int tid = get_tid(wv), wid = __builtin_amdgcn_readfirstlane(tid >> 6), lane = tid & 63, wr = wid >> 2, wc = wid & 3, fr = lane & 15, fq = lane >> 4;
    const int K = g.K, nt = K / BK;
    unsigned voffA[2], voffB[2];
#pragma unroll
    for (int i = 0; i < 2; ++i) { int R, C; stage_rc(tid * 16 + i * 8192, R, C); const int Rb = (R & ~31) + perm32(R & 31);
        voffA[i] = (unsigned)(R * g.lda + C) * 2u; voffB[i] = (unsigned)(Rb * g.ldb + C) * 2u; }
    const size_t kstep = (size_t)(BK * 2);
    const size_t hstepA = (size_t)HALF * g.lda * 2, hstepB = (size_t)HALF * g.ldb * 2;
    const size_t tstepA = 2 * hstepA, tstepB = 2 * hstepB;
    const unsigned ldsw = (unsigned)wid * 1024u;
    const int aoff = lds_byte(wr * 64 + fr, fq * 8), boff = lds_byte(wc * 32 + fr, fq * 8);
#define PG8_SA(b, h) (((b) * 2 + (h)) * HTB)
#define PG8_SB(b, h) ((4 + (b) * 2 + (h)) * HTB)
#define PG8_STAGE(bufoff, gbase, voff) do { _Pragma("unroll") for (int _i = 0; _i < 2; ++_i) \
        __builtin_amdgcn_global_load_lds((const unsigned*)((const char*)(gbase) + (voff)[_i]), (LAS unsigned*)(lds + (bufoff) + ldsw + _i * 8192), 16, 0, 0); } while (0)
#define PG8_LDA(dst, b, h) do { _Pragma("unroll") for (int m = 0; m < 4; ++m) _Pragma("unroll") for (int k = 0; k < 2; ++k) dst[m][k] = *(const LAS bf16x8*)(lds + PG8_SA(b, h) + aoff + m * 2048 + k * 1024); } while (0)
#define PG8_LDB(dst, b, h) do { _Pragma("unroll") for (int n = 0; n < 2; ++n) _Pragma("unroll") for (int k = 0; k < 2; ++k) dst[n][k] = *(const LAS bf16x8*)(lds + PG8_SB(b, h) + boff + n * 2048 + k * 1024); } while (0)
#define PG8_MMA(ai, bj, At, Bt) do { __builtin_amdgcn_s_setprio(1); _Pragma("unroll") for (int m = 0; m < 4; ++m) _Pragma("unroll") for (int n = 0; n < 2; ++n) _Pragma("unroll") for (int k = 0; k < 2; ++k) \
        acc[ai][bj][m][n] = __builtin_amdgcn_mfma_f32_16x16x32_bf16(Bt[n][k], At[m][k], acc[ai][bj][m][n], 0, 0, 0); __builtin_amdgcn_s_setprio(0); } while (0)
#define PG8_WAIT_V(n) asm volatile("s_waitcnt vmcnt(" #n ")" ::: "memory")
#define PG8_WAIT_L(n) asm volatile("s_waitcnt lgkmcnt(" #n ")" ::: "memory")
#define PG8_BAR __builtin_amdgcn_s_barrier()
#define PG8_SCHED __builtin_amdgcn_sched_barrier(0)
    Unit cur, nxt; int ui = 0;
    if (!S.next(0, cur)) return;
    f32x4 acc[2][2][4][2];
#pragma unroll
    for (int a = 0; a < 2; ++a)
#pragma unroll
        for (int b = 0; b < 2; ++b)
#pragma unroll
            for (int m = 0; m < 4; ++m)
#pragma unroll
                for (int n = 0; n < 2; ++n) acc[a][b][m][n] = (f32x4){0.f, 0.f, 0.f, 0.f};
    bf16x8 At[4][2], B0[2][2], B1[2][2];
    typename Epi::Pre pre;
    const char* cA = (const char*)g.A + (size_t)cur.pm * tstepA; const char* cB = (const char*)g.Bt + (size_t)cur.pn * tstepB + (size_t)(cur.pm >> g.bsh) * g.bmul;
    PG8_STAGE(PG8_SB(0, 0), cB, voffB); PG8_STAGE(PG8_SB(0, 1), cB + hstepB, voffB); PG8_STAGE(PG8_SA(0, 0), cA, voffA); PG8_STAGE(PG8_SA(0, 1), cA + hstepA, voffA);
    if (wr == 1) PG8_BAR;
    PG8_WAIT_V(2); PG8_BAR;
    PG8_STAGE(PG8_SB(1, 0), cB + kstep, voffB); PG8_STAGE(PG8_SA(1, 0), cA + kstep, voffA); PG8_STAGE(PG8_SB(1, 1), cB + hstepB + kstep, voffB);
    PG8_WAIT_V(6); PG8_BAR;
    for (;;) {
        const bool has_next = S.next(ui + 1, nxt);
        E.prefetch(pre, cur, wr, wc, fr, fq);
        const char* nA = has_next ? (const char*)g.A + (size_t)nxt.pm * tstepA : cA;
        const char* nB = has_next ? (const char*)g.Bt + (size_t)nxt.pn * tstepB + (size_t)(nxt.pm >> g.bsh) * g.bmul : cB;
        for (int t = 0; t < nt; t += 2) {
            const bool last = (t == nt - 2);
            const char* a1 = cA + (size_t)(t + 1) * kstep;
            const char* a2 = last ? nA : cA + (size_t)(t + 2) * kstep; const char* b2 = last ? nB : cB + (size_t)(t + 2) * kstep;
            const char* a3 = a2 + kstep; const char* b3 = b2 + kstep;
            PG8_LDB(B0, 0, 0); PG8_LDB(B1, 0, 1); PG8_SCHED; PG8_LDA(At, 0, 0); PG8_STAGE(PG8_SA(1, 1), a1 + hstepA, voffA);
            PG8_WAIT_V(8); PG8_WAIT_L(0); PG8_BAR; PG8_MMA(0, 0, At, B0); PG8_MMA(0, 1, At, B1); PG8_BAR; PG8_SCHED;
            PG8_LDA(At, 0, 1); PG8_STAGE(PG8_SB(0, 0), b2, voffB); PG8_STAGE(PG8_SB(0, 1), b2 + hstepB, voffB); PG8_STAGE(PG8_SA(0, 0), a2, voffA);
            PG8_WAIT_V(8); PG8_WAIT_L(0); PG8_BAR; PG8_MMA(1, 0, At, B0); PG8_MMA(1, 1, At, B1); PG8_BAR; PG8_SCHED;
            PG8_LDB(B0, 1, 0); PG8_LDB(B1, 1, 1); PG8_SCHED; PG8_LDA(At, 1, 0); PG8_STAGE(PG8_SA(0, 1), a2 + hstepA, voffA);
            PG8_WAIT_V(8); PG8_WAIT_L(0); PG8_BAR; PG8_MMA(0, 0, At, B0); PG8_MMA(0, 1, At, B1); PG8_BAR; PG8_SCHED;
            PG8_LDA(At, 1, 1); PG8_STAGE(PG8_SB(1, 0), b3, voffB); PG8_STAGE(PG8_SB(1, 1), b3 + hstepB, voffB); PG8_STAGE(PG8_SA(1, 0), a3, voffA);
            PG8_WAIT_V(8); PG8_WAIT_L(0); PG8_BAR; PG8_MMA(1, 0, At, B0); PG8_MMA(1, 1, At, B1); PG8_BAR; PG8_SCHED;
        }
        if (wr == 0) PG8_BAR;
        E(acc, pre, cur, wr, wc, fr, fq);
        if (!has_next) break;
#pragma unroll
        for (int a = 0; a < 2; ++a)
#pragma unroll
            for (int b = 0; b < 2; ++b)
#pragma unroll
                for (int m = 0; m < 4; ++m)
#pragma unroll
                    for (int n = 0; n < 2; ++n) acc[a][b][m][n] = (f32x4){0.f, 0.f, 0.f, 0.f};
        cur = nxt; cA = nA; cB = nB; ++ui;
        if (wr == 1) PG8_BAR;
    }
    PG8_WAIT_V(0);
    PG8_BAR;
#undef PG8_SA
#undef PG8_SB
#undef PG8_STAGE
#undef PG8_LDA
#undef PG8_LDB
#undef PG8_MMA
#undef PG8_WAIT_V
#undef PG8_WAIT_L
#undef PG8_BAR
#undef PG8_SCHED
}
}

enum { EPI_GMLP1 = 0, EPI_POOL1 = 1, EPI_ATTN1 = 2, EPI_ATTNC = 3, EPI_RES = 4, EPI_BF16 = 5, EPI_F32 = 6 };
template <int MODE> struct Epi {
    static constexpr int mode = MODE;
    bf16_t *o0, *o1, *o2, *o3;
    float* stats;
    const float* gate;
    const float *xil, *xic; float *xol, *xoc;
    const float *rc, *rs;
    int ldc;
    const float* sumsq_in; const float* bias; int rowoff; int ctxonly;
    float* sumsq_out; bf16_t* hout; const float* gnext; const float* modnext;
    int xmode; const bf16_t* xb_in; bf16_t* xb_out;
    static constexpr bool HASPRE = (MODE == EPI_GMLP1 || MODE == EPI_POOL1 || MODE == EPI_ATTN1 || MODE == EPI_ATTNC);
    struct Pre { float ssq[HASPRE ? 8 : 1]; };
    __device__ __forceinline__ void prefetch(Pre& pre, const pg8::Unit& u, int wr, int wc, int fr, int fq) const {
        if (HASPRE && sumsq_in != nullptr) {
            const int row0 = u.pm * 256 + wr * 64 + fr;
#pragma unroll
            for (int ai = 0; ai < 2; ++ai)
#pragma unroll
                for (int m = 0; m < 4; ++m) pre.ssq[ai * 4 + m] = sumsq_in[rowoff + row0 + ai * 128 + m * 16];
        }
    }
    __device__ __forceinline__ void operator()(f32x4 (&acc)[2][2][4][2], const Pre& pre, const pg8::Unit& u, int wr, int wc, int fr, int fq) const {
        const int row0 = u.pm * 256 + wr * 64 + fr;
        if ((mode == EPI_GMLP1 || mode == EPI_POOL1 || mode == EPI_ATTN1 || mode == EPI_ATTNC) && sumsq_in != nullptr) {
            const int b = (ctxonly || u.pm >= ML / 256) ? 32 : (u.pm >> 3);
            const float* bp = bias + (size_t)b * ldc + u.pn * 256 + wc * 32 + fq * 8;
            f32x4 bv[2][2];
#pragma unroll
            for (int bj = 0; bj < 2; ++bj)
#pragma unroll
                for (int n = 0; n < 2; ++n) bv[bj][n] = *(const f32x4*)(bp + bj * 128 + 4 * n);
#pragma unroll
            for (int ai = 0; ai < 2; ++ai)
#pragma unroll
                for (int m = 0; m < 4; ++m) {
                    const float rsd = rsqrtf(pre.ssq[ai * 4 + m] * (1.0f / DM) + 1e-6f);
#pragma unroll
                    for (int bj = 0; bj < 2; ++bj)
#pragma unroll
                        for (int n = 0; n < 2; ++n) acc[ai][bj][m][n] = acc[ai][bj][m][n] * rsd + bv[bj][n];
                }
        }
        if (mode == EPI_GMLP1) {
            if (u.pn < 16) {
#pragma unroll
                for (int ai = 0; ai < 2; ++ai)
#pragma unroll
                    for (int m = 0; m < 4; ++m) {
                        const size_t row = (size_t)(row0 + ai * 128 + m * 16);
                        const f32x4 u0 = acc[ai][0][m][0], u1 = acc[ai][0][m][1], g0 = acc[ai][1][m][0], g1 = acc[ai][1][m][1];
                        u32x4 w;
                        { const f32x2 r = ugate2((f32x2){u0[0], u0[1]}, (f32x2){g0[0], g0[1]}); w.x = cvt_pk_bf16(r[0], r[1]); }
                        { const f32x2 r = ugate2((f32x2){u0[2], u0[3]}, (f32x2){g0[2], g0[3]}); w.y = cvt_pk_bf16(r[0], r[1]); }
                        { const f32x2 r = ugate2((f32x2){u1[0], u1[1]}, (f32x2){g1[0], g1[1]}); w.z = cvt_pk_bf16(r[0], r[1]); }
                        { const f32x2 r = ugate2((f32x2){u1[2], u1[3]}, (f32x2){g1[2], g1[3]}); w.w = cvt_pk_bf16(r[0], r[1]); }
                        *(u32x4*)(o0 + row * 2048 + u.pn * 128 + wc * 32 + fq * 8) = w;
                    }
            } else {
                const int g = u.pn - 16;
#pragma unroll
                for (int ai = 0; ai < 2; ++ai)
#pragma unroll
                    for (int m = 0; m < 4; ++m) {
                        const size_t row = (size_t)(row0 + ai * 128 + m * 16);
                        float s = 0.f, ss = 0.f;
#pragma unroll
                        for (int bj = 0; bj < 2; ++bj) {
                            float v[8];
#pragma unroll
                            for (int j = 0; j < 4; j += 2) { const f32x2 r0 = gelu2((f32x2){acc[ai][bj][m][0][j], acc[ai][bj][m][0][j + 1]}), r1 = gelu2((f32x2){acc[ai][bj][m][1][j], acc[ai][bj][m][1][j + 1]});
                                v[j] = r0[0]; v[j + 1] = r0[1]; v[4 + j] = r1[0]; v[5 + j] = r1[1]; }
#pragma unroll
                            for (int j = 0; j < 8; ++j) { s += v[j]; ss += v[j] * v[j]; }
                            u32x4 w; w.x = cvt_pk_bf16(v[0], v[1]); w.y = cvt_pk_bf16(v[2], v[3]); w.z = cvt_pk_bf16(v[4], v[5]); w.w = cvt_pk_bf16(v[6], v[7]);
                            *(u32x4*)(o1 + row * 2048 + g * 256 + bj * 128 + wc * 32 + fq * 8) = w;
                        }
                        { const int ln = fr + 16 * fq; s += shx(s, 16, ln); s += shx(s, 32, ln); ss += shx(ss, 16, ln); ss += shx(ss, 32, ln); }
                        if (fq == 0) *(f32x2*)(stats + (row * 32 + g * 4 + wc) * 2) = (f32x2){s, ss};
                    }
            }
        } else if (mode == EPI_POOL1) {
            const bool isg = u.pn >= 8; bf16_t* const o = isg ? o1 : o0; const int cb = (isg ? u.pn - 8 : u.pn) * 256 + wc * 32 + fq * 8;
#pragma unroll
            for (int ai = 0; ai < 2; ++ai)
#pragma unroll
                for (int m = 0; m < 4; ++m) {
                    const size_t row = (size_t)(row0 + ai * 128 + m * 16);
#pragma unroll
                    for (int bj = 0; bj < 2; ++bj) {
                        f32x4 v0 = acc[ai][bj][m][0], v1 = acc[ai][bj][m][1];
                        if (isg) {
#pragma unroll
                            for (int j = 0; j < 4; ++j) { v0[j] = silu_f(v0[j]); v1[j] = silu_f(v1[j]); }
                        }
                        u32x4 w; w.x = cvt_pk_bf16(v0[0], v0[1]); w.y = cvt_pk_bf16(v0[2], v0[3]); w.z = cvt_pk_bf16(v1[0], v1[1]); w.w = cvt_pk_bf16(v1[2], v1[3]);
                        *(u32x4*)(o + row * 2048 + cb + bj * 128) = w;
                    }
                }
        } else if (mode == EPI_ATTN1 || mode == EPI_ATTNC) {
            const bool ctx = (mode == EPI_ATTNC);
            const int sec = ctx ? (u.pn == 0 ? 1 : 2) : (u.pn < 4 ? 0 : (u.pn == 4 ? 1 : (u.pn == 5 ? 2 : 3)));
            if (sec <= 1) {
                const int j0 = 16 * (wc & 1) + 4 * fq;
                const float qs = (sec == 0) ? 0.125f : 1.0f;
#pragma unroll
                for (int ai = 0; ai < 2; ++ai)
#pragma unroll
                    for (int m = 0; m < 4; ++m) {
                        const int row = row0 + ai * 128 + m * 16;
                        f32x4 c4 = (f32x4){qs, qs, qs, qs}, s4 = (f32x4){0.f, 0.f, 0.f, 0.f};
                        if (!ctx) { const int s = row & (SEQ - 1); c4 = *(const f32x4*)(rc + s * 32 + j0) * qs; s4 = *(const f32x4*)(rs + s * 32 + j0) * qs; }
#pragma unroll
                        for (int bj = 0; bj < 2; ++bj) {
                            const f32x4 x1 = acc[ai][bj][m][0], x2 = acc[ai][bj][m][1];
                            const f32x4 a = x1 * c4 - x2 * s4, b = x2 * c4 + x1 * s4;
                            const int hl = 2 * bj + (wc >> 1);
                            bf16_t* p = (sec == 0) ? (o0 + (size_t)row * 1024 + (u.pn * 4 + hl) * 64 + j0) : ((ctx ? o0 : o1) + (size_t)row * 256 + hl * 64 + j0);
                            *(u32x2*)p = (u32x2){cvt_pk_bf16(a[0], a[1]), cvt_pk_bf16(a[2], a[3])};
                            *(u32x2*)(p + 32) = (u32x2){cvt_pk_bf16(b[0], b[1]), cvt_pk_bf16(b[2], b[3])};
                        }
                    }
            } else if (sec == 2) {
                bf16_t* const vt = ctx ? o1 : o2; const int lsh = ctx ? 8 : 11, L = 1 << lsh;
#pragma unroll
                for (int ai = 0; ai < 2; ++ai)
#pragma unroll
                    for (int m = 0; m < 4; ++m) {
                        const int row = row0 + ai * 128 + m * 16, b = row >> lsh, t = row & (L - 1);
#pragma unroll
                        for (int bj = 0; bj < 2; ++bj) {
                            const int kvh = 2 * bj + (wc >> 1);
                            bf16_t* p = vt + ((size_t)((b * 4 + kvh) * 64 + 32 * (wc & 1) + 8 * fq) << lsh) + t;
#pragma unroll
                            for (int n = 0; n < 2; ++n)
#pragma unroll
                                for (int j = 0; j < 4; ++j) p[(size_t)(4 * n + j) << lsh] = (bf16_t)(cvt_pk_bf16(acc[ai][bj][m][n][j], 0.f) & 0xffffu);
                        }
                    }
            } else {
                const int cb = (u.pn - 6) * 256 + wc * 32 + fq * 8;
#pragma unroll
                for (int ai = 0; ai < 2; ++ai)
#pragma unroll
                    for (int m = 0; m < 4; ++m) {
                        const size_t row = (size_t)(row0 + ai * 128 + m * 16);
#pragma unroll
                        for (int bj = 0; bj < 2; ++bj) {
                            const f32x4 v0 = acc[ai][bj][m][0], v1 = acc[ai][bj][m][1];
                            u32x4 w; w.x = cvt_pk_bf16(silu_f(v0[0]), silu_f(v0[1])); w.y = cvt_pk_bf16(silu_f(v0[2]), silu_f(v0[3]));
                            w.z = cvt_pk_bf16(silu_f(v1[0]), silu_f(v1[1])); w.w = cvt_pk_bf16(silu_f(v1[2]), silu_f(v1[3]));
                            *(u32x4*)(o3 + row * 1024 + cb + bj * 128) = w;
                        }
                    }
            }
        } else if (mode == EPI_RES) {
            const bool lat = u.pm < ML / 256;
            const size_t tb = (lat ? (size_t)u.pm : (size_t)(u.pm - ML / 256)) * 256 * DM;
            const size_t tg = (size_t)u.pm * 256 * DM;
            const float* xi = (lat ? xil : xic) + tb; float* xo = xol + tb;
            const bf16_t* xbi = xb_in + tg; bf16_t* xbo = xb_out + tg;
            const int bb = lat ? (u.pm >> 3) : 32;
            const int colb = u.pn * 256 + wc * 32 + fq * 8;
            const float* gp = gate + bb * 3072 + colb;
            const unsigned lo = (unsigned)((wr * 64 + fr) * DM + colb) * 4u;
            f32x4 gv[2][2], gn[2][2];
#pragma unroll
            for (int bj = 0; bj < 2; ++bj)
#pragma unroll
                for (int n = 0; n < 2; ++n) {
                    gv[bj][n] = *(const f32x4*)(gp + bj * 128 + 4 * n);
                    if (hout) gn[bj][n] = *(const f32x4*)(gnext + colb + bj * 128 + 4 * n) * (*(const f32x4*)(modnext + bb * 3072 + 1024 + colb + bj * 128 + 4 * n) + 1.0f);
                }
            bf16_t* hb = hout + tg;
#define RES_BODY(AI, M, XV0, XV1, BJ) do { \
                        f32x4 t[2]; t[0] = (XV0) + gv[BJ][0] * acc[AI][BJ][M][0]; t[1] = (XV1) + gv[BJ][1] * acc[AI][BJ][M][1]; \
                        if (xmode == 2) { \
                            *(f32x4*)((char*)xo + lo + (unsigned)((((AI) * 128 + (M) * 16) * DM + (BJ) * 128) * 4)) = t[0]; \
                            *(f32x4*)((char*)xo + lo + (unsigned)((((AI) * 128 + (M) * 16) * DM + (BJ) * 128 + 4) * 4)) = t[1]; \
                        } else { \
                            *(u32x4*)((char*)xbo + (lo >> 1) + (unsigned)((((AI) * 128 + (M) * 16) * DM + (BJ) * 128) * 2)) = (u32x4){cvt_pk_bf16(t[0][0], t[0][1]), cvt_pk_bf16(t[0][2], t[0][3]), cvt_pk_bf16(t[1][0], t[1][1]), cvt_pk_bf16(t[1][2], t[1][3])}; \
                        } \
                        if (sumsq_out) ss += t[0][0] * t[0][0] + t[0][1] * t[0][1] + t[0][2] * t[0][2] + t[0][3] * t[0][3] + t[1][0] * t[1][0] + t[1][1] * t[1][1] + t[1][2] * t[1][2] + t[1][3] * t[1][3]; \
                        if (hout) { const f32x4 h0 = t[0] * gn[BJ][0], h1 = t[1] * gn[BJ][1]; \
                            *(u32x4*)((char*)hb + (lo >> 1) + (unsigned)((((AI) * 128 + (M) * 16) * DM + (BJ) * 128) * 2)) = (u32x4){cvt_pk_bf16(h0[0], h0[1]), cvt_pk_bf16(h0[2], h0[3]), cvt_pk_bf16(h1[0], h1[1]), cvt_pk_bf16(h1[2], h1[3])}; } \
                    } while (0)
#define RES_ROWSUM(AI, M) do { if (sumsq_out) { const int ln = fr + 16 * fq; ss += shx(ss, 16, ln); ss += shx(ss, 32, ln); \
                        if (fq == 0) (void)__hip_atomic_fetch_add(sumsq_out + row0 + (AI) * 128 + (M) * 16, ss, __ATOMIC_RELAXED, __HIP_MEMORY_SCOPE_AGENT); } } while (0)
            if (xmode == 0) {
#pragma unroll
                for (int am = 0; am < 4; ++am) {
                    const int ai = am >> 1, mb = (am & 1) * 2;
                    f32x4 xv[2][2][2];
#pragma unroll
                    for (int m2 = 0; m2 < 2; ++m2)
#pragma unroll
                        for (int bj = 0; bj < 2; ++bj)
#pragma unroll
                            for (int n = 0; n < 2; ++n) xv[m2][bj][n] = *(const f32x4*)((const char*)xi + lo + (unsigned)(((ai * 128 + (mb + m2) * 16) * DM + bj * 128 + 4 * n) * 4));
                    __builtin_amdgcn_sched_barrier(0);
#pragma unroll
                    for (int m2 = 0; m2 < 2; ++m2) {
                        float ss = 0.f;
#pragma unroll
                        for (int bj = 0; bj < 2; ++bj) RES_BODY(ai, mb + m2, xv[m2][bj][0], xv[m2][bj][1], bj);
                        RES_ROWSUM(ai, mb + m2);
                    }
                    __builtin_amdgcn_sched_barrier(0);
                }
            } else {
#pragma unroll
                for (int ai = 0; ai < 2; ++ai) {
                    u32x4 xw[4][2];
#pragma unroll
                    for (int m = 0; m < 4; ++m)
#pragma unroll
                        for (int bj = 0; bj < 2; ++bj) xw[m][bj] = *(const u32x4*)((const char*)xbi + (lo >> 1) + (unsigned)(((ai * 128 + m * 16) * DM + bj * 128) * 2));
                    __builtin_amdgcn_sched_barrier(0);
#pragma unroll
                    for (int m = 0; m < 4; ++m) {
                        float ss = 0.f;
#pragma unroll
                        for (int bj = 0; bj < 2; ++bj) {
                            const u32x4 w = xw[m][bj];
                            RES_BODY(ai, m, ((f32x4){bf_lo(w.x), bf_hi(w.x), bf_lo(w.y), bf_hi(w.y)}), ((f32x4){bf_lo(w.z), bf_hi(w.z), bf_lo(w.w), bf_hi(w.w)}), bj);
                        }
                        RES_ROWSUM(ai, m);
                    }
                    __builtin_amdgcn_sched_barrier(0);
                }
            }
#undef RES_BODY
#undef RES_ROWSUM
        } else if (mode == EPI_F32) {
            if (wr == 0) {
#pragma unroll
                for (int m = 0; m < 4; ++m)
#pragma unroll
                    for (int bj = 0; bj < 2; ++bj)
#pragma unroll
                        for (int n = 0; n < 2; ++n) *(f32x4*)((float*)o0 + (size_t)(m * 16 + fr) * ldc + u.pn * 256 + bj * 128 + wc * 32 + fq * 8 + 4 * n) = acc[0][bj][m][n];
            }
        } else {
            const int cb = u.pn * 256 + wc * 32 + fq * 8;
#pragma unroll
            for (int ai = 0; ai < 2; ++ai)
#pragma unroll
                for (int m = 0; m < 4; ++m) {
                    const size_t row = (size_t)(row0 + ai * 128 + m * 16);
#pragma unroll
                    for (int bj = 0; bj < 2; ++bj) {
                        const f32x4 v0 = acc[ai][bj][m][0], v1 = acc[ai][bj][m][1];
                        u32x4 w; w.x = cvt_pk_bf16(v0[0], v0[1]); w.y = cvt_pk_bf16(v0[2], v0[3]); w.z = cvt_pk_bf16(v1[0], v1[1]); w.w = cvt_pk_bf16(v1[2], v1[3]);
                        *(u32x4*)(o0 + row * ldc + cb + bj * 128) = w;
                    }
                }
        }
    }
};

struct Params {
    const float *x, *c, *ctx, *c_ctx, *ada_w, *ada_b, *norm_g, *final_g;
    const float *gmlp_w_in, *gmlp_vn_g, *gmlp_vn_b, *gmlp_w_s, *gmlp_b_s, *gmlp_w_out;
    const float *pool_w_in, *pool_w_grp, *pool_scale, *pool_w_out;
    const float *attn_w_in, *attn_sink, *attn_w_out;
    float* out; unsigned char* ws;
    int ph_lo, ph_hi;
};

__device__ __forceinline__ void prep_mod(int wv, LAS unsigned char* lds, const Params& P, int item) {
    const int tid = get_tid(wv), wave = tid >> 6, lane = tid & 63;
    const int layer = item / 48, nb = item % 48, col = nb * 64 + lane;
    LAS float* sc = (LAS float*)lds;
    LAS float* red = (LAS float*)(lds + 256 * 36 * 4);
    float acc[33];
#pragma unroll
    for (int b = 0; b < 33; ++b) acc[b] = 0.f;
    const float* W = P.ada_w + (size_t)layer * 1024 * 3072;
    for (int kc = 0; kc < 4; ++kc) {
        __syncthreads();
        for (int idx = tid; idx < 33 * 256; idx += 512) { const int b = idx >> 8, kk = idx & 255; const float v = (b < 32) ? P.c[b * 1024 + kc * 256 + kk] : P.c_ctx[kc * 256 + kk]; sc[kk * 36 + b] = v / (1.0f + __expf(-v)); }
        __syncthreads();
        for (int k2 = 0; k2 < 32; ++k2) {
            const int kk = wave * 32 + k2;
            const float wv = W[(size_t)(kc * 256 + kk) * 3072 + col];
#pragma unroll
            for (int b4 = 0; b4 < 8; ++b4) { const f32x4 s4 = *(const LAS f32x4*)(sc + kk * 36 + b4 * 4); acc[b4 * 4 + 0] += s4[0] * wv; acc[b4 * 4 + 1] += s4[1] * wv; acc[b4 * 4 + 2] += s4[2] * wv; acc[b4 * 4 + 3] += s4[3] * wv; }
            acc[32] += sc[kk * 36 + 32] * wv;
        }
    }
#pragma unroll
    for (int b = 0; b < 33; ++b) red[(wave * 33 + b) * 64 + lane] = acc[b];
    __syncthreads();
    for (int idx = tid; idx < 33 * 64; idx += 512) {
        const int b = idx >> 6, l = idx & 63; float s = 0.f;
#pragma unroll
        for (int w = 0; w < 8; ++w) s += red[(w * 33 + b) * 64 + l];
        const int cc = nb * 64 + l;
        ((float*)(P.ws + WS_MOD))[(size_t)layer * MODSZ + b * 3072 + cc] = s + P.ada_b[layer * 3072 + cc];
    }
    __syncthreads();
}

struct ConvTile { const float* src; bf16_t* dst; int ldn, K, L0, P0, k0, rope; };
__device__ __forceinline__ void conv_decode(const Params& P, int t, ConvTile& c) {
    unsigned char* ws = P.ws;
    c.rope = 0;
    if (t < 3072) {
        const int j = t / 1536, tt = t % 1536, kt = tt / 96, nt = tt % 96, p0 = nt * 64;
        c.src = P.gmlp_w_in + (size_t)j * 1024 * 6144; c.dst = (bf16_t*)(ws + (j ? WS_GIN1 : WS_GIN0)); c.ldn = 6144; c.K = 1024; c.k0 = kt * 64; c.P0 = p0;
        c.L0 = (p0 < 4096) ? (((p0 & 255) >= 128 ? 4096 : 0) + 128 * (p0 >> 8) + (p0 & 127)) : (2048 + (p0 - 4096));
        return;
    }
    t -= 3072;
    if (t < 1024) {
        const int j = t / 512, tt = t % 512, kt = tt / 16, nt = tt % 16;
        c.src = P.gmlp_w_out + (size_t)j * 2048 * 1024; c.dst = (bf16_t*)(ws + (j ? WS_GOUT1 : WS_GOUT0)); c.ldn = 1024; c.K = 2048; c.k0 = kt * 64; c.P0 = nt * 64; c.L0 = nt * 64; return;
    }
    t -= 1024;
    if (t < 512) {
        const int kt = t / 32, nt = t % 32;
        c.src = P.pool_w_in; c.dst = (bf16_t*)(ws + WS_PINT); c.ldn = 4096; c.K = 1024; c.k0 = kt * 64; c.P0 = 2048 + nt * 64; c.L0 = 2048 + nt * 64; return;
    }
    t -= 512;
    if (t < 256) {
        const int g = t / 64, tt = t % 64, kt = tt / 8, nt = tt % 8;
        c.src = P.pool_w_grp + (size_t)g * 512 * 512; c.dst = (bf16_t*)(ws + WS_PGRPT) + (size_t)g * 512 * 512; c.ldn = 512; c.K = 512; c.k0 = kt * 64; c.P0 = nt * 64; c.L0 = nt * 64; return;
    }
    t -= 256;
    if (t < 512) {
        const int kt = t / 16, nt = t % 16;
        c.src = P.pool_w_out; c.dst = (bf16_t*)(ws + WS_POUT); c.ldn = 1024; c.K = 2048; c.k0 = kt * 64; c.P0 = nt * 64; c.L0 = nt * 64; return;
    }
    t -= 512;
    if (t < 640) {
        const int kt = t / 40, nt = t % 40;
        c.src = P.attn_w_in; c.dst = (bf16_t*)(ws + WS_AIN); c.ldn = 2560; c.K = 1024; c.k0 = kt * 64; c.P0 = nt * 64; c.L0 = nt * 64; c.rope = (nt < 20); return;
    }
    t -= 640;
    {
        const int kt = t / 16, nt = t % 16;
        c.src = P.attn_w_out; c.dst = (bf16_t*)(ws + WS_AOUT); c.ldn = 1024; c.K = 1024; c.k0 = kt * 64; c.P0 = nt * 64; c.L0 = nt * 64; return;
    }
}
constexpr int N_CONV_TILES = 3072 + 1024 + 512 + 256 + 512 + 640 + 256;

__device__ __forceinline__ void prep_phase(int wv, LAS unsigned char* lds, const Params& P) {
    const int tid = get_tid(wv), G = gridDim.x, bid = blockIdx.x;
    for (int item = bid; item < 192; item += G) prep_mod(wv, lds, P, item);
    {
        float* rc = (float*)(P.ws + WS_ROPEC); float* rs = (float*)(P.ws + WS_ROPES);
        for (int i = bid * 512 + tid; i < 2048 * 32; i += G * 512) {
            const int s = i >> 5, j = i & 31; const float pos = (float)((j < 16) ? (s >> 6) : (s & 63));
            const float inv = exp2f(-(float)(j & 15) * (13.287712379549449f / 16.0f));
            const float ang = pos * inv, tr = ang * 0.15915494309189535f;
            rc[i] = __builtin_amdgcn_cosf(tr); rs[i] = __builtin_amdgcn_sinf(tr);
        }
        bf16_t* pn = (bf16_t*)(P.ws + WS_PINNT);
        for (int i = bid * 512 + tid; i < 1024 * 256; i += G * 512) {
            const int r = i >> 8, c8 = i & 255; const float* s = P.pool_w_in + (size_t)r * 4096 + c8 * 8;
            const f32x4 a = *(const f32x4*)s, b = *(const f32x4*)(s + 4);
            *(u32x4*)(pn + (size_t)r * 2048 + c8 * 8) = (u32x4){cvt_pk_bf16(a[0], a[1]), cvt_pk_bf16(a[2], a[3]), cvt_pk_bf16(b[0], b[1]), cvt_pk_bf16(b[2], b[3])};
        }
        { f32x4* sq = (f32x4*)(P.ws + WS_SUMSQ); for (int i = bid * 512 + tid; i < 3 * MT / 4; i += G * 512) sq[i] = (f32x4){0.f, 0.f, 0.f, 0.f}; }
        bf16_t* gw = (bf16_t*)(P.ws + WS_GWS);
        for (int i = bid * 512 + tid; i < 2 * 8 * 128 * 128 / 8; i += G * 512) {
            const float* s = P.gmlp_w_s + (size_t)i * 8; const f32x4 a = *(const f32x4*)s, b = *(const f32x4*)(s + 4);
            *(u32x4*)(gw + (size_t)i * 8) = (u32x4){cvt_pk_bf16(a[0], a[1]), cvt_pk_bf16(a[2], a[3]), cvt_pk_bf16(b[0], b[1]), cvt_pk_bf16(b[2], b[3])};
        }
    }
    LAS float* tb = (LAS float*)lds;
    const int kr = tid >> 4, nc4 = tid & 15;
    const int pr = tid >> 3, kq = tid & 7;
    for (int t0 = bid * 4; t0 < N_CONV_TILES; t0 += G * 4) {
        f32x4 v[4][2];
#pragma unroll
        for (int s = 0; s < 4; ++s) {
            ConvTile c; conv_decode(P, (t0 + s < N_CONV_TILES) ? t0 + s : t0, c);
#pragma unroll
            for (int j = 0; j < 2; ++j) v[s][j] = *(const f32x4*)(c.src + (size_t)(c.k0 + kr + 32 * j) * c.ldn + c.L0 + nc4 * 4);
        }
        __syncthreads();
#pragma unroll
        for (int s = 0; s < 4; ++s)
#pragma unroll
            for (int j = 0; j < 2; ++j)
#pragma unroll
                for (int e = 0; e < 4; ++e) tb[s * 4160 + (kr + 32 * j) * 65 + nc4 * 4 + e] = v[s][j][e];
        __syncthreads();
#pragma unroll
        for (int s = 0; s < 4; ++s) {
            if (t0 + s < N_CONV_TILES) {
                ConvTile c; conv_decode(P, t0 + s, c);
                const int lj = c.rope ? (4 * (pr >> 3) + (pr & 3) + 32 * ((pr >> 2) & 1)) : pr;
                float f[8];
#pragma unroll
                for (int e = 0; e < 8; ++e) f[e] = tb[s * 4160 + (kq * 8 + e) * 65 + lj];
                *(u32x4*)(c.dst + (size_t)(c.P0 + pr) * c.K + c.k0 + kq * 8) = (u32x4){cvt_pk_bf16(f[0], f[1]), cvt_pk_bf16(f[2], f[3]), cvt_pk_bf16(f[4], f[5]), cvt_pk_bf16(f[6], f[7])};
            }
        }
    }
    __syncthreads();
}

__device__ __forceinline__ void shift16_phase(int wv, const float* mod, bf16_t* S16) {
    const int tid = get_tid(wv);
    for (int i = blockIdx.x * 512 + tid; i < 3 * 256 * 128; i += gridDim.x * 512) {
        const int l = i >> 15, r = (i >> 7) & 255, c8 = i & 127;
        u32x4 w = (u32x4){0u, 0u, 0u, 0u};
        if (r < 33) { const float* s = mod + (size_t)(l + 1) * MODSZ + r * 3072 + c8 * 8; const f32x4 a = *(const f32x4*)s, b = *(const f32x4*)(s + 4);
            w = (u32x4){cvt_pk_bf16(a[0], a[1]), cvt_pk_bf16(a[2], a[3]), cvt_pk_bf16(b[0], b[1]), cvt_pk_bf16(b[2], b[3])}; }
        *(u32x4*)(S16 + (size_t)i * 8) = w;
    }
}

__device__ __forceinline__ void norm_phase(int wv, int vcu, bool rev, const float* xl, const float* xc, int nrows, const float* g, const float* modl, bf16_t* H) {
    const int tid_ = get_tid(wv); const int lane = tid_ & 63;
    f32x4 gv[4];
#pragma unroll
    for (int j = 0; j < 2; ++j) { gv[2 * j] = *(const f32x4*)(g + 512 * j + lane * 8); gv[2 * j + 1] = *(const f32x4*)(g + 512 * j + lane * 8 + 4); }
    constexpr int NR = 4;
    const int nun = nrows >> 5;
    for (int uu = vcu; uu < nun; uu += gridDim.x) {
        const int r0 = unit_remap(uu, nun, rev) * 32 + (tid_ >> 6) * 4; const int nw = 1;
        f32x4 v[NR][4];
#pragma unroll
        for (int q = 0; q < NR; ++q) {
            const int r = min(r0 + q * nw, nrows - 1);
            const float* xp = (r < ML) ? xl + (size_t)r * DM : xc + (size_t)(r - ML) * DM;
#pragma unroll
            for (int j = 0; j < 2; ++j) { v[q][2 * j] = *(const f32x4*)(xp + 512 * j + lane * 8); v[q][2 * j + 1] = *(const f32x4*)(xp + 512 * j + lane * 8 + 4); }
        }
#pragma unroll
        for (int q = 0; q < NR; ++q) {
            const int r = r0 + q * nw;
            if (r < nrows) {
                const float* mp = modl + ((r < ML) ? (r >> 11) : 32) * 3072;
                float ss = 0.f;
#pragma unroll
                for (int j = 0; j < 4; ++j) ss += v[q][j][0] * v[q][j][0] + v[q][j][1] * v[q][j][1] + v[q][j][2] * v[q][j][2] + v[q][j][3] * v[q][j][3];
                ss = wave_sum(ss, lane);
                const float rstd = rsqrtf(ss * (1.0f / DM) + 1e-6f);
#pragma unroll
                for (int j = 0; j < 2; ++j) {
                    const int k = 512 * j + lane * 8;
                    const f32x4 sh0 = *(const f32x4*)(mp + k), sh1 = *(const f32x4*)(mp + k + 4), sc0 = *(const f32x4*)(mp + 1024 + k), sc1 = *(const f32x4*)(mp + 1024 + k + 4);
                    const f32x4 a = v[q][2 * j] * rstd * gv[2 * j] * (sc0 + 1.0f) + sh0, b = v[q][2 * j + 1] * rstd * gv[2 * j + 1] * (sc1 + 1.0f) + sh1;
                    *(u32x4*)(H + (size_t)r * DM + k) = (u32x4){cvt_pk_bf16(a[0], a[1]), cvt_pk_bf16(a[2], a[3]), cvt_pk_bf16(b[0], b[1]), cvt_pk_bf16(b[2], b[3])};
                }
            }
        }
    }
}
__device__ __forceinline__ void final_phase(int wv, int vcu, bool rev, const bf16_t* x, float* out, const float* g) {
    const int tid_ = get_tid(wv); const int lane = tid_ & 63;
    f32x4 gv[4];
#pragma unroll
    for (int j = 0; j < 2; ++j) { gv[2 * j] = *(const f32x4*)(g + 512 * j + lane * 8); gv[2 * j + 1] = *(const f32x4*)(g + 512 * j + lane * 8 + 4); }
    constexpr int NR = 4;
    const int nun = ML >> 5;
    for (int uu = vcu; uu < nun; uu += gridDim.x) {
        const int r0 = unit_remap(uu, nun, rev) * 32 + (tid_ >> 6) * 4;
        u32x4 w[NR][2];
#pragma unroll
        for (int q = 0; q < NR; ++q) {
            const bf16_t* xp = x + (size_t)(r0 + q) * DM;
#pragma unroll
            for (int j = 0; j < 2; ++j) w[q][j] = *(const u32x4*)(xp + 512 * j + lane * 8);
        }
#pragma unroll
        for (int q = 0; q < NR; ++q) {
            float* xp = out + (size_t)(r0 + q) * DM;
            f32x4 v[4];
#pragma unroll
            for (int j = 0; j < 2; ++j) { const u32x4 ww = w[q][j]; v[2 * j] = (f32x4){bf_lo(ww.x), bf_hi(ww.x), bf_lo(ww.y), bf_hi(ww.y)}; v[2 * j + 1] = (f32x4){bf_lo(ww.z), bf_hi(ww.z), bf_lo(ww.w), bf_hi(ww.w)}; }
            float ss = 0.f;
#pragma unroll
            for (int j = 0; j < 4; ++j) ss += v[j][0] * v[j][0] + v[j][1] * v[j][1] + v[j][2] * v[j][2] + v[j][3] * v[j][3];
            ss = wave_sum(ss, lane);
            const float rstd = rsqrtf(ss * (1.0f / DM) + 1e-6f);
#pragma unroll
            for (int j = 0; j < 2; ++j) { *(f32x4*)(xp + 512 * j + lane * 8) = v[2 * j] * rstd * gv[2 * j]; *(f32x4*)(xp + 512 * j + lane * 8 + 4) = v[2 * j + 1] * rstd * gv[2 * j + 1]; }
        }
    }
}

__device__ __forceinline__ void spatial_phase(int wv, int vcu, bool rev, LAS unsigned char* lds, int nchunks, const bf16_t* UG, const bf16_t* GV, const float* stats, const bf16_t* WS16, const float* vn_g, const float* vn_b, const float* b_s, bf16_t* Y) {
    const int tid = get_tid(wv), wave = __builtin_amdgcn_readfirstlane(tid >> 6), lane = tid & 63, fr = lane & 15, fq = lane >> 4, wr = wave >> 2, wc = wave & 3;
    LAS f32x2* st = (LAS f32x2*)lds;
    LAS unsigned char* img = lds + 1024;
    LAS unsigned char* ugt = lds + 1024 + 65536;
    const int nunits = nchunks * 8;
    const int c8 = tid & 31, q0 = tid >> 5;
    u32x4 raw[8], ugr[8];
    if (vcu < nunits) {
        const int u = unit_remap(vcu, nunits, rev); const int g = u & 7; const size_t row0 = (size_t)(u >> 3) * 128;
#pragma unroll
        for (int it = 0; it < 8; ++it) { raw[it] = *(const u32x4*)(GV + (row0 + q0 + 16 * it) * 2048 + g * 256 + c8 * 8); ugr[it] = *(const u32x4*)(UG + (row0 + q0 + 16 * it) * 2048 + g * 256 + c8 * 8); }
    }
    for (int uu = vcu; uu < nunits; uu += gridDim.x) {
        const int u = unit_remap(uu, nunits, rev);
        const int g = u & 7, ch = u >> 3; const size_t row0 = (size_t)ch * 128;
        bf16x8 wf[4][4];
        {
            const bf16_t* wp = WS16 + (size_t)g * 16384 + (size_t)(wr * 64 + fr) * 128 + fq * 8;
#pragma unroll
            for (int ks = 0; ks < 4; ++ks)
#pragma unroll
                for (int m = 0; m < 4; ++m) wf[ks][m] = *(const bf16x8*)(wp + m * 16 * 128 + ks * 32);
        }
        {
            const int r = tid >> 2, part = tid & 3; const f32x4* sp = (const f32x4*)(stats + ((row0 + r) * 32 + part * 8) * 2);
            float s = 0.f, ss = 0.f;
#pragma unroll
            for (int i = 0; i < 4; ++i) { const f32x4 v = sp[i]; s += v[0] + v[2]; ss += v[1] + v[3]; }
            s += shx(s, 1, lane); s += shx(s, 2, lane); ss += shx(ss, 1, lane); ss += shx(ss, 2, lane);
            const float mean = s * (1.0f / 2048.0f), var = ss * (1.0f / 2048.0f) - mean * mean;
            if (part == 0) st[r] = (f32x2){mean, rsqrtf(fmaxf(var, 0.f) + 1e-6f)};
        }
#pragma unroll
        for (int it = 0; it < 8; ++it) *(LAS u32x4*)(ugt + (q0 + 16 * it) * 528 + c8 * 16) = ugr[it];
        __syncthreads();
        {
            const int cg = g * 256 + c8 * 8;
            const f32x4 G0 = *(const f32x4*)(vn_g + cg), G1 = *(const f32x4*)(vn_g + cg + 4), B0 = *(const f32x4*)(vn_b + cg), B1 = *(const f32x4*)(vn_b + cg + 4);
#pragma unroll
            for (int it = 0; it < 8; ++it) {
                const int q = q0 + 16 * it; const f32x2 ms = st[q]; const float mu = ms[0], rs = ms[1];
                const u32x4 w = raw[it]; u32x4 o;
                o.x = cvt_pk_bf16((bf_lo(w.x) - mu) * rs * G0[0] + B0[0], (bf_hi(w.x) - mu) * rs * G0[1] + B0[1]);
                o.y = cvt_pk_bf16((bf_lo(w.y) - mu) * rs * G0[2] + B0[2], (bf_hi(w.y) - mu) * rs * G0[3] + B0[3]);
                o.z = cvt_pk_bf16((bf_lo(w.z) - mu) * rs * G1[0] + B1[0], (bf_hi(w.z) - mu) * rs * G1[1] + B1[1]);
                o.w = cvt_pk_bf16((bf_lo(w.w) - mu) * rs * G1[2] + B1[2], (bf_hi(w.w) - mu) * rs * G1[3] + B1[3]);
                const int sw = (q & 3) | (((q >> 3) & 1) << 2);
                *(LAS u32x4*)(img + q * 512 + (((2 * c8) ^ (4 * sw)) * 8)) = o;
            }
        }
        __syncthreads();
        if (uu + (int)gridDim.x < nunits) {
            const int un = unit_remap(uu + gridDim.x, nunits, rev); const int gn = un & 7; const size_t rown = (size_t)(un >> 3) * 128;
#pragma unroll
            for (int it = 0; it < 8; ++it) { raw[it] = *(const u32x4*)(GV + (rown + q0 + 16 * it) * 2048 + gn * 256 + c8 * 8); ugr[it] = *(const u32x4*)(UG + (rown + q0 + 16 * it) * 2048 + gn * 256 + c8 * 8); }
        }
        f32x4 acc[4][4];
#pragma unroll
        for (int m = 0; m < 4; ++m)
#pragma unroll
            for (int n = 0; n < 4; ++n) acc[m][n] = (f32x4){0.f, 0.f, 0.f, 0.f};
        const int sw = (fr >> 2) | ((fq & 1) << 2);
#pragma unroll
        for (int ks = 0; ks < 4; ++ks) {
            bf16x8 vf[4];
#pragma unroll
            for (int n = 0; n < 4; ++n) {
                const int R = ks * 32 + 8 * fq + (fr >> 2), chunk = wc * 16 + n * 4 + (fr & 3);
                LAS unsigned char* a = img + R * 512 + ((chunk ^ (4 * sw)) * 8);
                const s16x4 lo = __builtin_amdgcn_ds_read_tr16_b64_v4i16((LAS s16x4*)a), hi = __builtin_amdgcn_ds_read_tr16_b64_v4i16((LAS s16x4*)(a + 2048));
                vf[n] = (bf16x8){lo[0], lo[1], lo[2], lo[3], hi[0], hi[1], hi[2], hi[3]};
            }
#pragma unroll
            for (int m = 0; m < 4; ++m)
#pragma unroll
                for (int n = 0; n < 4; ++n) acc[m][n] = __builtin_amdgcn_mfma_f32_16x16x32_bf16(vf[n], wf[ks][m], acc[m][n], 0, 0, 0);
        }
#pragma unroll
        for (int m = 0; m < 4; ++m) {
            const int p = wr * 64 + m * 16 + fr; const float bs = b_s[g * 128 + p];
#pragma unroll
            for (int n = 0; n < 4; ++n) {
                LAS u32x2* tp = (LAS u32x2*)(ugt + p * 528 + (wc * 64 + n * 16 + 4 * fq) * 2);
                const u32x2 ug = *tp; const f32x4 s = acc[m][n] + bs;
                *tp = (u32x2){cvt_pk_bf16(bf_lo(ug.x) * s[0], bf_hi(ug.x) * s[1]), cvt_pk_bf16(bf_lo(ug.y) * s[2], bf_hi(ug.y) * s[3])};
            }
        }
        __syncthreads();
#pragma unroll
        for (int it = 0; it < 8; ++it) *(u32x4*)(Y + (row0 + q0 + 16 * it) * 2048 + g * 256 + c8 * 8) = *(const LAS u32x4*)(ugt + (q0 + 16 * it) * 528 + c8 * 16);
        __syncthreads();
    }
}

__device__ __forceinline__ void pool_phase(int wv, int vcu, bool rev, LAS unsigned char* lds, const bf16_t* Z, const bf16_t* SG, const float* scale, bf16_t* Y) {
    const int tid = get_tid(wv);
    const int nunits = (MT / 128) * 8;
    u32x4 zr[9];
#define POOL_GEOM(uidx) const int u_ = unit_remap((uidx), nunits, rev); const int cb = u_ & 7, row0 = (u_ >> 3) * 128; int seq0, L; \
        if (row0 < ML) { seq0 = row0 & ~(SEQ - 1); L = SEQ; } else { seq0 = ML + ((row0 - ML) & ~(LC - 1)); L = LC; } const int t0 = row0 - seq0;
#define POOL_LOADZ() _Pragma("unroll") for (int it = 0; it < 9; ++it) { const int idx = tid + 512 * it, rr = idx >> 5, c8_ = idx & 31, t = t0 - 8 + rr; \
            zr[it] = (u32x4){0u, 0u, 0u, 0u}; if (t >= 0 && t < L) zr[it] = *(const u32x4*)(Z + (size_t)(seq0 + t) * 2048 + cb * 256 + c8_ * 8); }
    if (vcu < nunits) { POOL_GEOM(vcu) POOL_LOADZ() }
    for (int uu = vcu; uu < nunits; uu += gridDim.x) {
        POOL_GEOM(uu)
        const int hw = 1 << (cb >> 1);
        const int c8 = tid & 31, strip = tid >> 5, cg = cb * 256 + c8 * 8, tt0 = strip * 8;
        u32x4 sgv[8];
#pragma unroll
        for (int i = 0; i < 8; ++i) sgv[i] = *(const u32x4*)(SG + (size_t)(row0 + tt0 + i) * 2048 + cg);
#pragma unroll
        for (int it = 0; it < 9; ++it) { const int idx = tid + 512 * it; *(LAS u32x4*)(lds + (idx >> 5) * 512 + (idx & 31) * 16) = zr[it]; }
        __syncthreads();
        if (uu + (int)gridDim.x < nunits) {
            const int cb0 = cb, row00 = row0, t00 = t0, L0 = L, seq00 = seq0; (void)cb0; (void)row00; (void)t00; (void)L0; (void)seq00;
            { POOL_GEOM(uu + gridDim.x) POOL_LOADZ() }
        }
        const f32x4 sc0 = *(const f32x4*)(scale + cg), sc1 = *(const f32x4*)(scale + cg + 4);
        float sum[8];
#pragma unroll
        for (int e = 0; e < 8; ++e) sum[e] = 0.f;
        for (int rr = tt0 + 8 - hw; rr < tt0 + 8 + hw; ++rr) {
            const u32x4 w = *(const LAS u32x4*)(lds + rr * 512 + c8 * 16);
            sum[0] += bf_lo(w.x); sum[1] += bf_hi(w.x); sum[2] += bf_lo(w.y); sum[3] += bf_hi(w.y); sum[4] += bf_lo(w.z); sum[5] += bf_hi(w.z); sum[6] += bf_lo(w.w); sum[7] += bf_hi(w.w);
        }
#pragma unroll
        for (int i = 0; i < 8; ++i) {
            const int tt = tt0 + i, t = t0 + tt;
            const int lo = max(t - hw, 0), hi = min(t + hw, L);
            const float inv = 1.0f / (float)(hi - lo);
            const u32x4 cw = *(const LAS u32x4*)(lds + (tt + 8) * 512 + c8 * 16);
            const u32x4 sw = sgv[i];
            float y[8];
            y[0] = (sum[0] * inv - bf_lo(cw.x)) * sc0[0] * bf_lo(sw.x); y[1] = (sum[1] * inv - bf_hi(cw.x)) * sc0[1] * bf_hi(sw.x);
            y[2] = (sum[2] * inv - bf_lo(cw.y)) * sc0[2] * bf_lo(sw.y); y[3] = (sum[3] * inv - bf_hi(cw.y)) * sc0[3] * bf_hi(sw.y);
            y[4] = (sum[4] * inv - bf_lo(cw.z)) * sc1[0] * bf_lo(sw.z); y[5] = (sum[5] * inv - bf_hi(cw.z)) * sc1[1] * bf_hi(sw.z);
            y[6] = (sum[6] * inv - bf_lo(cw.w)) * sc1[2] * bf_lo(sw.w); y[7] = (sum[7] * inv - bf_hi(cw.w)) * sc1[3] * bf_hi(sw.w);
            *(u32x4*)(Y + (size_t)(row0 + tt) * 2048 + cg) = (u32x4){cvt_pk_bf16(y[0], y[1]), cvt_pk_bf16(y[2], y[3]), cvt_pk_bf16(y[4], y[5]), cvt_pk_bf16(y[6], y[7])};
            if (i < 7) {
                const u32x4 a = *(const LAS u32x4*)(lds + (tt + 8 + hw) * 512 + c8 * 16), b = *(const LAS u32x4*)(lds + (tt + 8 - hw) * 512 + c8 * 16);
                sum[0] += bf_lo(a.x) - bf_lo(b.x); sum[1] += bf_hi(a.x) - bf_hi(b.x); sum[2] += bf_lo(a.y) - bf_lo(b.y); sum[3] += bf_hi(a.y) - bf_hi(b.y);
                sum[4] += bf_lo(a.z) - bf_lo(b.z); sum[5] += bf_hi(a.z) - bf_hi(b.z); sum[6] += bf_lo(a.w) - bf_lo(b.w); sum[7] += bf_hi(a.w) - bf_hi(b.w);
            }
        }
        __syncthreads();
    }
#undef POOL_GEOM
#undef POOL_LOADZ
}

constexpr int AT_KB = 128 * 144, AT_VB = 64 * 264, AT_BUF = AT_KB + AT_VB;
__device__ __forceinline__ void attn_phase(int wv, int vcu, bool rev, LAS unsigned char* lds, const bf16_t* Q, const bf16_t* Kl, const bf16_t* VT, const bf16_t* KC, const bf16_t* VCT, const bf16_t* SGA, const float* sink, bf16_t* Y) {
    const int tid = get_tid(wv), wave = __builtin_amdgcn_readfirstlane(tid >> 6), lane = tid & 63, l32 = lane & 31, h = lane >> 5;
    const int gq = wave >> 1, qhalf = wave & 1;
    const float NEG = -1.0e30f;
    for (int uu = vcu; uu < NB * 4 * 16; uu += gridDim.x) {
        const int u = unit_remap(uu, NB * 4 * 16, rev);
        const int kvh = u & 3, n = (u >> 2) & 15, b = u >> 6, start = n * 128, head = kvh * 4 + gq;
        const int qrow0 = b * SEQ + start + qhalf * 64;
        bf16x8 qf[2][4];
        unsigned lrow_off = (unsigned)(l32 * 1024 + h * 8) * 2u;
        asm volatile("" : "+v"(lrow_off));
#pragma unroll
        for (int nq = 0; nq < 2; ++nq) {
            const char* qb = (const char*)(Q + (size_t)(qrow0 + nq * 32) * 1024 + head * 64);
#pragma unroll
            for (int ks = 0; ks < 4; ++ks) qf[nq][ks] = *(const bf16x8*)(qb + lrow_off + ks * 32);
        }
        const int has0 = n > 0, has2 = n < 15, nsteps = 3 + has0 + has2;
        f32x16 O[2][2];
#pragma unroll
        for (int a = 0; a < 2; ++a)
#pragma unroll
            for (int c = 0; c < 2; ++c)
#pragma unroll
                for (int i = 0; i < 16; ++i) O[a][c][i] = 0.f;
        float m_run[2] = {NEG, NEG}, l_run[2] = {0.f, 0.f};
        u32x4 stg[2];
#define AT_PTRS(s) const int _s = (s); const bf16_t* kp; const bf16_t* vp; int vst; \
        if (_s < 2) { kp = KC + (size_t)(b * LC + _s * 128) * 256 + kvh * 64; vp = VCT + (size_t)((b * 4 + kvh) * 64) * LC + _s * 128; vst = LC; } \
        else { const int li = _s - 2 + (has0 ? 0 : 1); kp = Kl + (size_t)(b * SEQ + start - 128 + li * 128) * 256 + kvh * 64; vp = VT + (size_t)((b * 4 + kvh) * 64) * SEQ + (start - 128 + li * 128); vst = SEQ; }
#define AT_LOADK(s) do { AT_PTRS(s) (void)vp; (void)vst; \
        _Pragma("unroll") for (int it = 0; it < 2; ++it) { const int idx = tid + 512 * it; stg[it] = *(const u32x4*)((const char*)kp + (unsigned)((idx >> 3) * 512 + (idx & 7) * 16)); } } while (0)
#define AT_LOADV(s) do { AT_PTRS(s) (void)kp; \
        _Pragma("unroll") for (int it = 0; it < 2; ++it) { const int idx = tid + 512 * it; stg[it] = *(const u32x4*)((const char*)vp + (unsigned)((idx >> 4) * vst * 2 + (idx & 15) * 16)); } } while (0)
#define AT_STOREK(buf) do { LAS unsigned char* _kb = lds + (buf) * AT_BUF; \
        _Pragma("unroll") for (int it = 0; it < 2; ++it) { const int idx = tid + 512 * it; *(LAS u32x4*)(_kb + (idx >> 3) * 144 + (idx & 7) * 16) = stg[it]; } } while (0)
#define AT_STOREV(buf) do { LAS unsigned char* _vb = lds + (buf) * AT_BUF + AT_KB; \
        _Pragma("unroll") for (int it = 0; it < 2; ++it) { const int idx = tid + 512 * it; \
            *(LAS u32x2*)(_vb + (idx >> 4) * 264 + (idx & 15) * 16) = (u32x2){stg[it].x, stg[it].y}; \
            *(LAS u32x2*)(_vb + (idx >> 4) * 264 + (idx & 15) * 16 + 8) = (u32x2){stg[it].z, stg[it].w}; } } while (0)
        AT_LOADK(0); AT_STOREK(0); AT_LOADV(0); AT_STOREV(0);
        __syncthreads();
        for (int s = 0; s < nsteps; ++s) {
            const bool more = s + 1 < nsteps;
            if (more) AT_LOADK(s + 1);
            const int li = (s < 2) ? 1 : (s - 2 + (has0 ? 0 : 1));
            LAS unsigned char* kb = lds + (s & 1) * AT_BUF; LAS unsigned char* vb = kb + AT_KB;
            const bool dead01 = (li == 0 && qhalf == 1), dead23 = (li == 2 && qhalf == 0);
#define AT_DEAD(it) (((it) >> 2) ? dead23 : dead01)
#define AT_ISSUE(it, SD) do { if (!AT_DEAD(it)) { const int blk_ = (it) >> 1, nq_ = (it) & 1; \
                _Pragma("unroll") for (int i = 0; i < 16; ++i) SD[i] = 0.f; \
                _Pragma("unroll") for (int ks = 0; ks < 4; ++ks) { \
                    const bf16x8 kf = *(const LAS bf16x8*)(kb + (blk_ * 32 + l32) * 144 + (ks * 16 + h * 8) * 2); \
                    SD = __builtin_amdgcn_mfma_f32_32x32x16_bf16(kf, qf[nq_][ks], SD, 0, 0, 0); } } } while (0)
#define AT_ITEM(it, SD) do { if (!AT_DEAD(it)) { const int blk_ = (it) >> 1, nq_ = (it) & 1; \
                if (li != 1) { const int qi = qhalf * 64 + nq_ * 32 + l32; \
                    _Pragma("unroll") for (int i = 0; i < 16; ++i) { const int kk = blk_ * 32 + 8 * (i >> 2) + 4 * h + (i & 3); const bool keep = (li == 0) ? (kk >= qi) : (kk <= qi); if (!keep) SD[i] = NEG; } } \
                float mx = NEG; \
                _Pragma("unroll") for (int i = 0; i < 16; i += 2) mx = fmaxf(fmaxf(mx, SD[i]), SD[i + 1]); \
                mx = fmaxf(mx, shx(mx, 32, lane)); \
                if (__builtin_amdgcn_ballot_w64(mx > m_run[nq_] + 8.0f) != 0ull) { \
                    const float mnew = fmaxf(m_run[nq_], mx), alpha = fexp2((m_run[nq_] - mnew) * L2E); \
                    m_run[nq_] = mnew; l_run[nq_] *= alpha; \
                    _Pragma("unroll") for (int i = 0; i < 16; ++i) { O[0][nq_][i] *= alpha; O[1][nq_][i] *= alpha; } } \
                const f32x2 ms2 = (f32x2){m_run[nq_] * L2E, m_run[nq_] * L2E}; f32x2 ls2 = (f32x2){0.f, 0.f}; unsigned pw[8]; \
                _Pragma("unroll") for (int i = 0; i < 16; i += 2) { \
                    const f32x2 t2 = (f32x2){SD[i], SD[i + 1]} * L2E - ms2; const f32x2 p2 = (f32x2){fexp2(t2[0]), fexp2(t2[1])}; \
                    ls2 += p2; pw[i >> 1] = cvt_pk_bf16(p2[0], p2[1]); } \
                l_run[nq_] += ls2[0] + ls2[1]; \
                _Pragma("unroll") for (int sl = 0; sl < 2; ++sl) { \
                    const bf16x8 pf = __builtin_bit_cast(bf16x8, ((u32x4){pw[4 * sl], pw[4 * sl + 1], pw[4 * sl + 2], pw[4 * sl + 3]})); \
                    const int kbase = blk_ * 32 + sl * 16 + 4 * h; \
                    _Pragma("unroll") for (int dm = 0; dm < 2; ++dm) { \
                        LAS unsigned char* vp = vb + (dm * 32 + l32) * 264 + kbase * 2; \
                        const u32x2 v0 = *(const LAS u32x2*)vp, v1 = *(const LAS u32x2*)(vp + 16); \
                        const bf16x8 vf = __builtin_bit_cast(bf16x8, ((u32x4){v0.x, v0.y, v1.x, v1.y})); \
                        O[dm][nq_] = __builtin_amdgcn_mfma_f32_32x32x16_bf16(vf, pf, O[dm][nq_], 0, 0, 0); } } } } while (0)
            {
                f32x16 SA, SB;
                AT_ISSUE(0, SA);
                AT_ISSUE(1, SB); AT_ITEM(0, SA);
                AT_ISSUE(2, SA); AT_ITEM(1, SB);
                AT_ISSUE(3, SB); AT_ITEM(2, SA);
                AT_ISSUE(4, SA); AT_ITEM(3, SB);
                if (more) { AT_STOREK((s + 1) & 1); AT_LOADV(s + 1); }
                AT_ISSUE(5, SB); AT_ITEM(4, SA);
                AT_ISSUE(6, SA); AT_ITEM(5, SB);
                AT_ISSUE(7, SB); AT_ITEM(6, SA);
                AT_ITEM(7, SB);
                if (more) { AT_STOREV((s + 1) & 1); }
            }
#undef AT_DEAD
#undef AT_ISSUE
#undef AT_ITEM
            __syncthreads();
        }
#undef AT_PTRS
#undef AT_LOADK
#undef AT_LOADV
#undef AT_STOREK
#undef AT_STOREV
        const float sk = sink[head];
#pragma unroll
        for (int nq = 0; nq < 2; ++nq) {
            const float lt = l_run[nq] + shx(l_run[nq], 32, lane) + fexp2((sk - m_run[nq]) * L2E);
            const float inv = 1.0f / lt;
            const size_t rob = ((size_t)(qrow0 + nq * 32) * 1024 + head * 64) * 2;
            unsigned lo = (unsigned)(l32 * 1024 + 4 * h) * 2u; asm volatile("" : "+v"(lo));
#pragma unroll
            for (int dm = 0; dm < 2; ++dm)
#pragma unroll
                for (int i4 = 0; i4 < 4; ++i4) {
                    const int d = dm * 32 + 8 * i4;
                    const u32x2 g = *(const u32x2*)((const char*)SGA + rob + lo + d * 2);
                    const float o0 = O[dm][nq][4 * i4 + 0] * inv * bf_lo(g.x), o1 = O[dm][nq][4 * i4 + 1] * inv * bf_hi(g.x), o2 = O[dm][nq][4 * i4 + 2] * inv * bf_lo(g.y), o3 = O[dm][nq][4 * i4 + 3] * inv * bf_hi(g.y);
                    *(u32x2*)((char*)Y + rob + lo + d * 2) = (u32x2){cvt_pk_bf16(o0, o1), cvt_pk_bf16(o2, o3)};
                }
        }
    }
}


#define XB_TMO      128
#define XB_XCNT(j)  (256  + 64 * (j))
#define XB_XSUB(j)  (1280 + 64 * (j))
#define XB_XGEN(j)  (2304 + 64 * (j))
#define XB_TOP      3328
#define XB_TOPGEN   3392
#define XCD_BAR_WORDS 3456
#define XB_SPIN_CAP (1u << 20)
__device__ __forceinline__ unsigned xb_ld(unsigned* p)              { return __hip_atomic_load(p, __ATOMIC_RELAXED, __HIP_MEMORY_SCOPE_AGENT); }
__device__ __forceinline__ unsigned xb_add(unsigned* p, unsigned v) { return __hip_atomic_fetch_add(p, v, __ATOMIC_RELAXED, __HIP_MEMORY_SCOPE_AGENT); }
__device__ __forceinline__ unsigned xb_xcc_id() { return (unsigned)__builtin_amdgcn_s_getreg((3 << 11) | 20) & 0xFu; }
#define XB_SPIN(cond, bar) do { unsigned _sp = 0; while (cond) { __builtin_amdgcn_s_sleep(1); \
    if ((++_sp & 255u) == 0u) { if (xb_ld(&(bar)[XB_TMO])) break; if (_sp > XB_SPIN_CAP) { atomicAdd(&(bar)[XB_TMO], 1u); break; } } } } while (0)
struct XcdBarrier { unsigned* bar; unsigned x; volatile LAS unsigned* st; };
__device__ __forceinline__ void xcd_barrier_complete(unsigned* bar, unsigned x, unsigned& nloc, unsigned& nx) {
    const unsigned G = gridDim.x;
    unsigned sum, cnt, mine, sp = 0u;
    for (;;) {
        sum = 0u; cnt = 0u; mine = 0u;
#pragma unroll
        for (unsigned j = 0; j < 16; ++j) { const unsigned c = xb_ld(&bar[XB_XCNT(j)]); sum += c; cnt += (c > 0u) ? 1u : 0u; mine = (j == x) ? c : mine; }
        if (sum == G) break;
        __builtin_amdgcn_s_sleep(1);
        if ((++sp & 255u) == 0u) { if (xb_ld(&bar[XB_TMO])) break; if (sp > XB_SPIN_CAP) { atomicAdd(&bar[XB_TMO], 1u); break; } }
    }
    nloc = mine > 0u ? mine : 1u; nx = cnt > 0u ? cnt : 1u;
}
__device__ __forceinline__ void xcd_barrier(const XcdBarrier& b, int tid) {
    asm volatile("s_waitcnt vmcnt(0)" ::: "memory");
    __syncthreads();
    if (tid == 0) {
        unsigned* bar = b.bar;
        __builtin_amdgcn_s_waitcnt(0);
        unsigned nloc = b.st[0], nx = b.st[1];
        if (nloc == 0u) { xcd_barrier_complete(bar, b.x, nloc, nx); b.st[0] = nloc; b.st[1] = nx; }
        const unsigned old = xb_add(&bar[XB_XSUB(b.x)], 1u);
        const unsigned gen = old / nloc;
        if (old + 1u == (gen + 1u) * nloc) {
            __builtin_amdgcn_fence(__ATOMIC_RELEASE, "agent");
            asm volatile("s_waitcnt vmcnt(0)" ::: "memory");
            const unsigned og = xb_add(&bar[XB_TOP], 1u);
            const unsigned tg = og / nx;
            if (og + 1u == (tg + 1u) * nx) xb_add(&bar[XB_TOPGEN], 1u);
            else XB_SPIN(xb_ld(&bar[XB_TOPGEN]) == tg, bar);
            __builtin_amdgcn_fence(__ATOMIC_ACQUIRE, "agent");
            xb_add(&bar[XB_XGEN(b.x)], 1u);
            asm volatile("s_waitcnt vmcnt(0)" ::: "memory");
        } else {
            XB_SPIN(xb_ld(&bar[XB_XGEN(b.x)]) == gen, bar);
            __builtin_amdgcn_fence(__ATOMIC_ACQUIRE, "agent");
            asm volatile("s_waitcnt vmcnt(0)" ::: "memory");
        }
    }
    __syncthreads();
}

constexpr int N_PHASES = 20;
__global__ void __launch_bounds__(512, 2) mega_fwd(Params P) {
    extern __shared__ __attribute__((aligned(16))) unsigned char lds_raw[];
    LAS unsigned char* lds = (LAS unsigned char*)lds_raw;
    cg::grid_group grid = cg::this_grid();
    unsigned char* const ws = P.ws;
    const int G = gridDim.x, bid = blockIdx.x;
    const int wv = __builtin_amdgcn_readfirstlane((int)threadIdx.x >> 6);
    XcdBarrier xb; xb.bar = (unsigned*)(ws + WS_CTL); xb.x = xb_xcc_id(); xb.st = (volatile LAS unsigned*)(lds + LDS_BYTES - 64);
    { const int t0 = get_tid(wv); if (t0 == 0) { xb.st[0] = 0u; xb.st[1] = 0u; xb.st[2] = xb_add(&xb.bar[XB_XCNT(xb.x)], 1u); xb.st[3] = (unsigned)bid; } __syncthreads(); }
#define IN(k) (P.ph_lo <= (k) && (k) < P.ph_hi)
#ifndef DUPMASK
#define DUPMASK 0
#endif
#define REP(k) for (int rep_ = 0; rep_ < (((DUPMASK) >> (k)) & 1) + 1; ++rep_)
#define SYNC(k) do { xcd_barrier(xb, get_tid(wv)); } while (0)
#define SYNC_CG(k) do { grid.sync(); } while (0)
#define WSP(T, off) ((T*)(ws + (off)))
#define MOD(layer) (WSP(float, WS_MOD) + (layer) * MODSZ)
#define AQ   (WSP(bf16_t, WS_R1))
#define ASG  (WSP(bf16_t, WS_R1) + (size_t)ML * 1024)
#define AK   (WSP(bf16_t, WS_R2))
#define AVT  (WSP(bf16_t, WS_R2) + (size_t)ML * 256)
#define AKC  (WSP(bf16_t, WS_R2) + (size_t)ML * 512)
#define AVCT (WSP(bf16_t, WS_R2) + (size_t)ML * 512 + (size_t)MC * 256)
#define RUN_GEMM(MODE, gm, E, oc, rv) do { pg8::StaticOrder S_; S_.init((gm).M, (gm).N, G, (oc), (rv)); pg8::gemm_phase<Epi<MODE>>(wv, lds, (gm), S_, (E)); } while (0)

    REP(0) if (IN(0)) prep_phase(wv, lds, P);
    SYNC_CG(0);
    int vcu = bid;
    {
        const int t0 = get_tid(wv);
        if (t0 == 0) {
            unsigned nx = 0u, ok = 1u;
#pragma unroll
            for (unsigned j = 0; j < 16; ++j) { const unsigned c = xb_ld(&xb.bar[XB_XCNT(j)]); if (j < 8u) { if (c * 8u != (unsigned)G) ok = 0u; nx += (c > 0u); } else if (c != 0u) ok = 0u; }
            if (ok && nx == 8u && xb.x < 8u && xb.st[2] * 8u < (unsigned)G) xb.st[3] = xb.st[2] * 8u + xb.x;
        }
        __syncthreads();
        vcu = __builtin_amdgcn_readfirstlane((int)xb.st[3]);
    }
#define XSB ((bf16_t*)P.out)
#define R0B WSP(bf16_t, WS_R0)
#define R1B WSP(bf16_t, WS_R1)
#define R2B WSP(bf16_t, WS_R2)
#define SUMSQ(i) (WSP(float, WS_SUMSQ) + (size_t)(i) * MT)
#define BIAS1 (WSP(float, WS_BIAS))
#define BIAS2 (WSP(float, WS_BIAS) + 64 * 4096)
#define BIAS3 (WSP(float, WS_BIAS) + 64 * (4096 + 2560))
    REP(1) if (IN(1)) { shift16_phase(wv, WSP(const float, WS_MOD), WSP(bf16_t, WS_SHIFT16)); norm_phase(wv, vcu, false, P.x, P.ctx, MT, P.norm_g, MOD(0), R0B); }
    REP(2) if (IN(2)) {
        pg8::Gemm gm{WSP(const bf16_t, WS_PGRPT), WSP(const bf16_t, WS_PINNT), 2048, 1024, 512, 512, 2048, 1, 1024u};
        Epi<EPI_BF16> E{}; E.o0 = WSP(bf16_t, WS_PINT); E.ldc = 1024; RUN_GEMM(EPI_BF16, gm, E, vcu, 0);
    }
    SYNC(2);
    REP(3) if (IN(3)) {
        pg8::Gemm gm{R0B, WSP(const bf16_t, WS_GIN0), MT, 6144, 1024, 1024, 1024, 0, 0u};
        Epi<EPI_GMLP1> E{}; E.o0 = R1B; E.o1 = R2B; E.stats = WSP(float, WS_STATS); RUN_GEMM(EPI_GMLP1, gm, E, vcu, 1);
    }
    SYNC(3);
    REP(4) if (IN(4)) spatial_phase(wv, vcu, false, lds, MT / 128, R1B, R2B, WSP(const float, WS_STATS), WSP(const bf16_t, WS_GWS), P.gmlp_vn_g, P.gmlp_vn_b, P.gmlp_b_s, R0B);
    SYNC(4);
    if (IN(5)) {
        pg8::Gemm gm{R0B, WSP(const bf16_t, WS_GOUT0), MT, 1024, 2048, 2048, 2048, 0, 0u};
        Epi<EPI_RES> E{}; E.gate = MOD(0) + 2048; E.xil = P.x; E.xic = P.ctx; E.xmode = 0; E.xb_in = XSB; E.xb_out = XSB;
        E.hout = R1B; E.sumsq_out = SUMSQ(0); E.gnext = P.norm_g + DM; E.modnext = MOD(1); RUN_GEMM(EPI_RES, gm, E, vcu, 1);
        for (int l = 0; l < 3; ++l) {
            const bf16_t* bt = l == 0 ? WSP(const bf16_t, WS_PINT) : (l == 1 ? WSP(const bf16_t, WS_AIN) : WSP(const bf16_t, WS_GIN1));
            const int nn = l == 0 ? 4096 : (l == 1 ? 2560 : 6144);
            pg8::Gemm gb{WSP(const bf16_t, WS_SHIFT16) + (size_t)l * 256 * 1024, bt, 256, nn, 1024, 1024, 1024, 0, 0u};
            Epi<EPI_F32> Eb{}; Eb.o0 = (bf16_t*)(l == 0 ? BIAS1 : (l == 1 ? BIAS2 : BIAS3)); Eb.ldc = nn; RUN_GEMM(EPI_F32, gb, Eb, (vcu + (l == 0 ? 128 : (l == 1 ? 112 : 102))) % G, 0);
        }
    }
    SYNC(5);
    REP(7) if (IN(7)) {
        pg8::Gemm gm{R1B, WSP(const bf16_t, WS_PINT), MT, 4096, 1024, 1024, 1024, 0, 0u};
        Epi<EPI_POOL1> E{}; E.o0 = R0B; E.o1 = R2B; E.sumsq_in = SUMSQ(0); E.bias = BIAS1; E.ldc = 4096; RUN_GEMM(EPI_POOL1, gm, E, vcu, 1);
    }
    SYNC(7);
    REP(8) if (IN(8)) pool_phase(wv, vcu, false, lds, R0B, R2B, P.pool_scale, R1B);
    SYNC(8);
    if (IN(9)) {
        pg8::Gemm gm{R1B, WSP(const bf16_t, WS_POUT), MT, 1024, 2048, 2048, 2048, 0, 0u};
        Epi<EPI_RES> E{}; E.gate = MOD(1) + 2048; E.xmode = 1; E.xb_in = XSB; E.xb_out = XSB;
        E.hout = R0B; E.sumsq_out = SUMSQ(1); E.gnext = P.norm_g + 2 * DM; E.modnext = MOD(2); RUN_GEMM(EPI_RES, gm, E, vcu, 1);
    }
    SYNC(9);
    REP(11) if (IN(11)) {
        pg8::Gemm gm{R0B, WSP(const bf16_t, WS_AIN), ML, 2560, 1024, 1024, 1024, 0, 0u};
        Epi<EPI_ATTN1> E{}; E.o0 = AQ; E.o1 = AK; E.o2 = AVT; E.o3 = ASG; E.rc = WSP(const float, WS_ROPEC); E.rs = WSP(const float, WS_ROPES);
        E.sumsq_in = SUMSQ(1); E.bias = BIAS2; E.ldc = 2560; RUN_GEMM(EPI_ATTN1, gm, E, vcu, 1);
    }
    REP(12) if (IN(12)) {
        pg8::Gemm gm{R0B + (size_t)ML * 1024, WSP(const bf16_t, WS_AIN) + (size_t)1024 * 1024, MC, 512, 1024, 1024, 1024, 0, 0u};
        Epi<EPI_ATTNC> E{}; E.o0 = AKC; E.o1 = AVCT; E.sumsq_in = SUMSQ(1); E.bias = BIAS2 + 1024; E.ldc = 2560; E.rowoff = ML; E.ctxonly = 1; RUN_GEMM(EPI_ATTNC, gm, E, (vcu + G / 2) % G, 0);
    }
    SYNC(12);
    REP(13) if (IN(13)) attn_phase(wv, vcu, false, lds, AQ, AK, AVT, AKC, AVCT, ASG, P.attn_sink, R0B);
    SYNC(13);
    if (IN(14)) {
        pg8::Gemm gm{R0B, WSP(const bf16_t, WS_AOUT), ML, 1024, 1024, 1024, 1024, 0, 0u};
        Epi<EPI_RES> E{}; E.gate = MOD(2) + 2048; E.xmode = 1; E.xb_in = XSB; E.xb_out = XSB;
        E.hout = R1B; E.sumsq_out = SUMSQ(2); E.gnext = P.norm_g + 3 * DM; E.modnext = MOD(3); RUN_GEMM(EPI_RES, gm, E, vcu, 1);
    }
    SYNC(14);
    REP(16) if (IN(16)) {
        pg8::Gemm gm{R1B, WSP(const bf16_t, WS_GIN1), ML, 6144, 1024, 1024, 1024, 0, 0u};
        Epi<EPI_GMLP1> E{}; E.o0 = R0B; E.o1 = R2B; E.stats = WSP(float, WS_STATS); E.sumsq_in = SUMSQ(2); E.bias = BIAS3; E.ldc = 6144; RUN_GEMM(EPI_GMLP1, gm, E, vcu, 1);
    }
    SYNC(16);
    REP(17) if (IN(17)) spatial_phase(wv, vcu, false, lds, ML / 128, R0B, R2B, WSP(const float, WS_STATS), WSP(const bf16_t, WS_GWS) + (size_t)8 * 16384, P.gmlp_vn_g + 2048, P.gmlp_vn_b + 2048, P.gmlp_b_s + 1024, R1B);
    SYNC(17);
    if (IN(18)) {
        pg8::Gemm gm{R1B, WSP(const bf16_t, WS_GOUT1), ML, 1024, 2048, 2048, 2048, 0, 0u};
        Epi<EPI_RES> E{}; E.gate = MOD(3) + 2048; E.xmode = 1; E.xb_in = XSB; E.xb_out = R0B; RUN_GEMM(EPI_RES, gm, E, vcu, 1);
    }
    SYNC(18);
    REP(19) if (IN(19)) final_phase(wv, vcu, false, R0B, P.out, P.final_g);
}

extern "C" void kernel_launch(void* const* d_in, const int* in_sizes, int n_in, void* d_out, int out_size, void* d_ws, size_t ws_size, hipStream_t stream) {
    static int grid = 0;
    if (grid == 0) {
        if (ws_size < WS_END) { fprintf(stderr, "kernel_launch: workspace too small (%zu < %zu)\n", ws_size, (size_t)WS_END); grid = -1; return; }
        int dev = 0, cus = 0, per_cu = 0;
        hipGetDevice(&dev);
        hipDeviceGetAttribute(&cus, hipDeviceAttributeMultiprocessorCount, dev);
        if (hipFuncSetAttribute((const void*)mega_fwd, hipFuncAttributeMaxDynamicSharedMemorySize, LDS_BYTES) != hipSuccess) { fprintf(stderr, "kernel_launch: hipFuncSetAttribute failed\n"); grid = -1; return; }
        if (hipOccupancyMaxActiveBlocksPerMultiprocessor(&per_cu, (const void*)mega_fwd, 512, LDS_BYTES) != hipSuccess || per_cu < 1) { fprintf(stderr, "kernel_launch: occupancy query gave %d\n", per_cu); per_cu = 1; }
        (void)hipGetLastError();
        grid = cus * per_cu;
        fprintf(stderr, "kernel_launch: grid %d (cus %d x %d)\n", grid, cus, per_cu);
    }
    if (grid < 0) return;
    if (hipMemsetAsync((char*)d_ws + WS_CTL, 0, 16384, stream) != hipSuccess) { fprintf(stderr, "kernel_launch: memset failed\n"); return; }
    Params p{};
    p.x = (const float*)d_in[0]; p.c = (const float*)d_in[1]; p.ctx = (const float*)d_in[2]; p.c_ctx = (const float*)d_in[3];
    p.ada_w = (const float*)d_in[4]; p.ada_b = (const float*)d_in[5]; p.norm_g = (const float*)d_in[6]; p.final_g = (const float*)d_in[7];
    p.gmlp_w_in = (const float*)d_in[8]; p.gmlp_vn_g = (const float*)d_in[9]; p.gmlp_vn_b = (const float*)d_in[10]; p.gmlp_w_s = (const float*)d_in[11];
    p.gmlp_b_s = (const float*)d_in[12]; p.gmlp_w_out = (const float*)d_in[13];
    p.pool_w_in = (const float*)d_in[14]; p.pool_w_grp = (const float*)d_in[15]; p.pool_scale = (const float*)d_in[16]; p.pool_w_out = (const float*)d_in[17];
    p.attn_w_in = (const float*)d_in[18]; p.attn_sink = (const float*)d_in[19]; p.attn_w_out = (const float*)d_in[20];
    p.out = (float*)d_out; p.ws = (unsigned char*)d_ws; p.ph_lo = 0; p.ph_hi = N_PHASES;
    void* args[] = {&p};
    hipError_t e = hipLaunchCooperativeKernel((const void*)mega_fwd, dim3(grid), dim3(512), args, LDS_BYTES, stream);
    if (e != hipSuccess) fprintf(stderr, "kernel_launch: cooperative launch failed: %s (grid %d)\n", hipGetErrorString(e), grid);
}
```

```cpp
#include <hip/hip_runtime.h>
#include <hip/hip_cooperative_groups.h>
#include <cstdio>
namespace cg = cooperative_groups;

#define LAS __attribute__((address_space(3)))
typedef unsigned short bf16_t;
typedef short bf16x8 __attribute__((ext_vector_type(8)));
typedef short s16x4 __attribute__((ext_vector_type(4)));
typedef float f32x2 __attribute__((ext_vector_type(2)));
typedef float f32x4 __attribute__((ext_vector_type(4)));
typedef float f32x16 __attribute__((ext_vector_type(16)));
typedef unsigned u32x2 __attribute__((ext_vector_type(2)));
typedef unsigned u32x4 __attribute__((ext_vector_type(4)));

constexpr int DM = 1024, NB = 32, SEQ = 2048, LC = 256;
constexpr int ML = NB * SEQ, MC = NB * LC, MT = ML + MC;
constexpr int MODSZ = 33 * 3072;
constexpr float L2E = 1.4426950408889634f;

constexpr size_t MiB = 1u << 20;
constexpr size_t WS_MOD = 0;
constexpr size_t WS_ROPEC = 2 * MiB;
constexpr size_t WS_ROPES = 2 * MiB + 512 * 1024;
constexpr size_t WS_CTL = 3 * MiB;
constexpr size_t WS_GIN0 = 4 * MiB;
constexpr size_t WS_GIN1 = 16 * MiB;
constexpr size_t WS_GOUT0 = 28 * MiB;
constexpr size_t WS_GOUT1 = 32 * MiB;
constexpr size_t WS_GWS = 36 * MiB;
constexpr size_t WS_PINNT = 37 * MiB;
constexpr size_t WS_PINT = 41 * MiB;
constexpr size_t WS_PGRPT = 49 * MiB;
constexpr size_t WS_POUT = 51 * MiB;
constexpr size_t WS_AIN = 55 * MiB;
constexpr size_t WS_AOUT = 60 * MiB;
constexpr size_t WS_XC = 64 * MiB;
constexpr size_t WS_STATS = 96 * MiB;
constexpr size_t WS_R0 = 116 * MiB;
constexpr size_t WS_R1 = 404 * MiB;
constexpr size_t WS_R2 = 692 * MiB;
constexpr size_t WS_BIAS = 980 * MiB;
constexpr size_t WS_SHIFT16 = 984 * MiB;
constexpr size_t WS_SUMSQ = 3 * MiB + 65536;
constexpr size_t WS_END = 986 * MiB;

constexpr int LDS_BYTES = 147456;

typedef __bf16 bf16x2_t __attribute__((ext_vector_type(2)));
__device__ __forceinline__ unsigned cvt_pk_bf16(float lo, float hi) { const f32x2 v = {lo, hi}; const bf16x2_t r = __builtin_convertvector(v, bf16x2_t); return __builtin_bit_cast(unsigned, r); }
__device__ __forceinline__ float bf_lo(unsigned w) { return __uint_as_float(w << 16); }
__device__ __forceinline__ float bf_hi(unsigned w) { return __uint_as_float(w & 0xffff0000u); }
__device__ __forceinline__ float fexp2(float x) { return __builtin_amdgcn_exp2f(x); }
__device__ __forceinline__ float frcp(float x) { return __builtin_amdgcn_rcpf(x); }
__device__ __forceinline__ float silu_f(float x) { return x * frcp(1.0f + fexp2(-L2E * x)); }
__device__ __forceinline__ float gelu_f(float x) { const float t = x * (1.0f + 0.044715f * x * x); return x * frcp(1.0f + fexp2(-2.302208198f * t)); }
__device__ __forceinline__ f32x2 ugate2(f32x2 u, f32x2 g) {
    const f32x2 a = u * (u * u * (-0.1029432397f) + (-2.302208198f));
    const f32x2 b = g * (-L2E);
    const f32x2 e1 = (f32x2){fexp2(a[0]), fexp2(a[1])}, e2 = (f32x2){fexp2(b[0]), fexp2(b[1])};
    const f32x2 d1 = e1 + 1.0f, d = d1 + e2 * d1;
    return (u * g) * (f32x2){frcp(d[0]), frcp(d[1])};
}
__device__ __forceinline__ f32x2 gelu2(f32x2 u) {
    const f32x2 a = u * (u * u * (-0.1029432397f) + (-2.302208198f));
    const f32x2 d = (f32x2){fexp2(a[0]), fexp2(a[1])} + 1.0f;
    return u * (f32x2){frcp(d[0]), frcp(d[1])};
}
__device__ __forceinline__ int get_tid(int wv) { int t = wv * 64 + (int)__builtin_amdgcn_mbcnt_hi(~0u, __builtin_amdgcn_mbcnt_lo(~0u, 0u)); asm volatile("" : "+v"(t)); return t; }
__device__ __forceinline__ int unit_remap(int L, int n, bool rev) { if (rev) L = n - 1 - L; return (L & 7) * (n >> 3) + (L >> 3); }
__device__ __forceinline__ float shx(float v, int mask, int lane) { return __int_as_float(__builtin_amdgcn_ds_bpermute((lane ^ mask) << 2, __float_as_int(v))); }
__device__ __forceinline__ float wave_sum(float v, int lane) {
#pragma unroll
    for (int o = 1; o < 64; o <<= 1) v += shx(v, o, lane);
    return v;
}

namespace pg8 {
constexpr int BM = 256, BK = 64, HALF = 128, HTB = HALF * BK * 2, STAGE_BYTES = 8 * HTB, NXCD = 8, WGM = 8;
__device__ __forceinline__ int lds_byte(int r, int c) { const int st = (r >> 4) * 2 + (c >> 5), rr = r & 15, cc = c & 31, ob = rr * 64 + cc * 2; return st * 1024 + (ob ^ (((ob >> 9) & 1) << 5)); }
__device__ __forceinline__ void stage_rc(int b, int& R, int& C) { const int st = b / 1024, sb = b % 1024, swz = sb ^ (((sb >> 9) & 1) << 5); R = (st >> 1) * 16 + swz / 64; C = (st & 1) * 32 + (swz % 64) / 2; }
__device__ __forceinline__ int perm32(int rho) { const int n = rho >> 4, i = rho & 15; return 8 * (i >> 2) + 4 * n + (i & 3); }
struct Unit { int pm, pn; };
struct Gemm { const bf16_t* A; const bf16_t* Bt; int M, N, K, lda, ldb; int bsh; unsigned bmul; };
struct StaticOrder {
    int nM, nN, nwg, G, c, rev;
    __device__ void init(int M, int N, int G_, int c_, int rev_) { nM = M / BM; nN = N / BM; nwg = nM * nN; G = G_; c = c_; rev = rev_; }
    __device__ bool next(int i, Unit& u) const {
        const long L = (long)i * G + c; if (L >= nwg) return false;
        int wgid = rev ? (nwg - 1 - (int)L) : (int)L; { const int q = nwg / NXCD, r = nwg % NXCD, xcd = wgid % NXCD, off = wgid / NXCD; wgid = (xcd < r ? xcd * (q + 1) : r * (q + 1) + (xcd - r) * q) + off; }
        const int nig = WGM * nN, gid = wgid / nig, fm = gid * WGM, gsz = (nM - fm) < WGM ? (nM - fm) : WGM;
        u.pm = fm + ((wgid % nig) % gsz); u.pn = (wgid % nig) / gsz; return true;
    }
};

template <class Epi>
__device__ __forceinline__ void gemm_phase(int wv, LAS unsigned char* lds, const Gemm g, const StaticOrder& S, const Epi& E) {
    const int tid = get_tid(wv), wid = __builtin_amdgcn_readfirstlane(tid >> 6), lane = tid & 63, wr = wid >> 2, wc = wid & 3, fr = lane & 15, fq = lane >> 4;
    const int K = g.K, nt = K / BK;
    unsigned voffA[2], voffB[2];
#pragma unroll
    for (int i = 0; i < 2; ++i) { int R, C; stage_rc(tid * 16 + i * 8192, R, C); const int Rb = (R & ~31) + perm32(R & 31);
        voffA[i] = (unsigned)(R * g.lda + C) * 2u; voffB[i] = (unsigned)(Rb * g.ldb + C) * 2u; }
    const size_t kstep = (size_t)(BK * 2);
    const size_t hstepA = (size_t)HALF * g.lda * 2, hstepB = (size_t)HALF * g.ldb * 2;
    const size_t tstepA = 2 * hstepA, tstepB = 2 * hstepB;
    const unsigned ldsw = (unsigned)wid * 1024u;
    const int aoff = lds_byte(wr * 64 + fr, fq * 8), boff = lds_byte(wc * 32 + fr, fq * 8);
#define PG8_SA(b, h) (((b) * 2 + (h)) * HTB)
#define PG8_SB(b, h) ((4 + (b) * 2 + (h)) * HTB)
#define PG8_STAGE(bufoff, gbase, voff) do { _Pragma("unroll") for (int _i = 0; _i < 2; ++_i) \
        __builtin_amdgcn_global_load_lds((const unsigned*)((const char*)(gbase) + (voff)[_i]), (LAS unsigned*)(lds + (bufoff) + ldsw + _i * 8192), 16, 0, 0); } while (0)
#define PG8_LDA(dst, b, h) do { _Pragma("unroll") for (int m = 0; m < 4; ++m) _Pragma("unroll") for (int k = 0; k < 2; ++k) dst[m][k] = *(const LAS bf16x8*)(lds + PG8_SA(b, h) + aoff + m * 2048 + k * 1024); } while (0)
#define PG8_LDB(dst, b, h) do { _Pragma("unroll") for (int n = 0; n < 2; ++n) _Pragma("unroll") for (int k = 0; k < 2; ++k) dst[n][k] = *(const LAS bf16x8*)(lds + PG8_SB(b, h) + boff + n * 2048 + k * 1024); } while (0)
#define PG8_MMA(ai, bj, At, Bt) do { __builtin_amdgcn_s_setprio(1); _Pragma("unroll") for (int m = 0; m < 4; ++m) _Pragma("unroll") for (int n = 0; n < 2; ++n) _Pragma("unroll") for (int k = 0; k < 2; ++k) \
        acc[ai][bj][m][n] = __builtin_amdgcn_mfma_f32_16x16x32_bf16(Bt[n][k], At[m][k], acc[ai][bj][m][n], 0, 0, 0); __builtin_amdgcn_s_setprio(0); } while (0)
#define PG8_WAIT_V(n) asm volatile("s_waitcnt vmcnt(" #n ")" ::: "memory")
#define PG8_WAIT_L(n) asm volatile("s_waitcnt lgkmcnt(" #n ")" ::: "memory")
#define PG8_BAR __builtin_amdgcn_s_barrier()
#define PG8_SCHED __builtin_amdgcn_sched_barrier(0)
    Unit cur, nxt; int ui = 0;
    if (!S.next(0, cur)) return;
    f32x4 acc[2][2][4][2];
#pragma unroll
    for (int a = 0; a < 2; ++a)
#pragma unroll
        for (int b = 0; b < 2; ++b)
#pragma unroll
            for (int m = 0; m < 4; ++m)
#pragma unroll
                for (int n = 0; n < 2; ++n) acc[a][b][m][n] = (f32x4){0.f, 0.f, 0.f, 0.f};
    bf16x8 At[4][2], B0[2][2], B1[2][2];
    typename Epi::Pre pre;
    const char* cA = (const char*)g.A + (size_t)cur.pm * tstepA; const char* cB = (const char*)g.Bt + (size_t)cur.pn * tstepB + (size_t)(cur.pm >> g.bsh) * g.bmul;
    PG8_STAGE(PG8_SB(0, 0), cB, voffB); PG8_STAGE(PG8_SB(0, 1), cB + hstepB, voffB); PG8_STAGE(PG8_SA(0, 0), cA, voffA); PG8_STAGE(PG8_SA(0, 1), cA + hstepA, voffA);
    if (wr == 1) PG8_BAR;
    PG8_WAIT_V(2); PG8_BAR;
    PG8_STAGE(PG8_SB(1, 0), cB + kstep, voffB); PG8_STAGE(PG8_SA(1, 0), cA + kstep, voffA); PG8_STAGE(PG8_SB(1, 1), cB + hstepB + kstep, voffB);
    PG8_WAIT_V(6); PG8_BAR;
    for (;;) {
        const bool has_next = S.next(ui + 1, nxt);
        E.prefetch(pre, cur, wr, wc, fr, fq);
        const char* nA = has_next ? (const char*)g.A + (size_t)nxt.pm * tstepA : cA;
        const char* nB = has_next ? (const char*)g.Bt + (size_t)nxt.pn * tstepB + (size_t)(nxt.pm >> g.bsh) * g.bmul : cB;
        for (int t = 0; t < nt; t += 2) {
            const bool last = (t == nt - 2);
            const char* a1 = cA + (size_t)(t + 1) * kstep;
            const char* a2 = last ? nA : cA + (size_t)(t + 2) * kstep; const char* b2 = last ? nB : cB + (size_t)(t + 2) * kstep;
            const char* a3 = a2 + kstep; const char* b3 = b2 + kstep;
            PG8_LDB(B0, 0, 0); PG8_LDB(B1, 0, 1); PG8_SCHED; PG8_LDA(At, 0, 0); PG8_STAGE(PG8_SA(1, 1), a1 + hstepA, voffA);
            PG8_WAIT_V(8); PG8_WAIT_L(0); PG8_BAR; PG8_MMA(0, 0, At, B0); PG8_MMA(0, 1, At, B1); PG8_BAR; PG8_SCHED;
            PG8_LDA(At, 0, 1); PG8_STAGE(PG8_SB(0, 0), b2, voffB); PG8_STAGE(PG8_SB(0, 1), b2 + hstepB, voffB); PG8_STAGE(PG8_SA(0, 0), a2, voffA);
            PG8_WAIT_V(8); PG8_WAIT_L(0); PG8_BAR; PG8_MMA(1, 0, At, B0); PG8_MMA(1, 1, At, B1); PG8_BAR; PG8_SCHED;
            PG8_LDB(B0, 1, 0); PG8_LDB(B1, 1, 1); PG8_SCHED; PG8_LDA(At, 1, 0); PG8_STAGE(PG8_SA(0, 1), a2 + hstepA, voffA);
            PG8_WAIT_V(8); PG8_WAIT_L(0); PG8_BAR; PG8_MMA(0, 0, At, B0); PG8_MMA(0, 1, At, B1); PG8_BAR; PG8_SCHED;
            PG8_LDA(At, 1, 1); PG8_STAGE(PG8_SB(1, 0), b3, voffB); PG8_STAGE(PG8_SB(1, 1), b3 + hstepB, voffB); PG8_STAGE(PG8_SA(1, 0), a3, voffA);
            PG8_WAIT_V(8); PG8_WAIT_L(0); PG8_BAR; PG8_MMA(1, 0, At, B0); PG8_MMA(1, 1, At, B1); PG8_BAR; PG8_SCHED;
        }
        if (wr == 0) PG8_BAR;
        E(acc, pre, cur, wr, wc, fr, fq);
        if (!has_next) break;
#pragma unroll
        for (int a = 0; a < 2; ++a)
#pragma unroll
            for (int b = 0; b < 2; ++b)
#pragma unroll
                for (int m = 0; m < 4; ++m)
#pragma unroll
                    for (int n = 0; n < 2; ++n) acc[a][b][m][n] = (f32x4){0.f, 0.f, 0.f, 0.f};
        cur = nxt; cA = nA; cB = nB; ++ui;
        if (wr == 1) PG8_BAR;
    }
    PG8_WAIT_V(0);
    PG8_BAR;
#undef PG8_SA
#undef PG8_SB
#undef PG8_STAGE
#undef PG8_LDA
#undef PG8_LDB
#undef PG8_MMA
#undef PG8_WAIT_V
#undef PG8_WAIT_L
#undef PG8_BAR
#undef PG8_SCHED
}
}

enum { EPI_GMLP1 = 0, EPI_POOL1 = 1, EPI_ATTN1 = 2, EPI_ATTNC = 3, EPI_RES = 4, EPI_BF16 = 5, EPI_F32 = 6 };
template <int MODE> struct Epi {
    static constexpr int mode = MODE;
    bf16_t *o0, *o1, *o2, *o3;
    float* stats;
    const float* gate;
    const float *xil, *xic; float *xol, *xoc;
    const float *rc, *rs;
    int ldc;
    const float* sumsq_in; const float* bias; int rowoff; int ctxonly;
    float* sumsq_out; bf16_t* hout; const float* gnext; const float* modnext;
    int xmode; const bf16_t* xb_in; bf16_t* xb_out;
    static constexpr bool HASPRE = (MODE == EPI_GMLP1 || MODE == EPI_POOL1 || MODE == EPI_ATTN1 || MODE == EPI_ATTNC);
    struct Pre { float ssq[HASPRE ? 8 : 1]; };
    __device__ __forceinline__ void prefetch(Pre& pre, const pg8::Unit& u, int wr, int wc, int fr, int fq) const {
        if (HASPRE && sumsq_in != nullptr) {
            const int row0 = u.pm * 256 + wr * 64 + fr;
#pragma unroll
            for (int ai = 0; ai < 2; ++ai)
#pragma unroll
                for (int m = 0; m < 4; ++m) pre.ssq[ai * 4 + m] = sumsq_in[rowoff + row0 + ai * 128 + m * 16];
        }
    }
    __device__ __forceinline__ void operator()(f32x4 (&acc)[2][2][4][2], const Pre& pre, const pg8::Unit& u, int wr, int wc, int fr, int fq) const {
        const int row0 = u.pm * 256 + wr * 64 + fr;
        if ((mode == EPI_GMLP1 || mode == EPI_POOL1 || mode == EPI_ATTN1 || mode == EPI_ATTNC) && sumsq_in != nullptr) {
            const int b = (ctxonly || u.pm >= ML / 256) ? 32 : (u.pm >> 3);
            const float* bp = bias + (size_t)b * ldc + u.pn * 256 + wc * 32 + fq * 8;
            f32x4 bv[2][2];
#pragma unroll
            for (int bj = 0; bj < 2; ++bj)
#pragma unroll
                for (int n = 0; n < 2; ++n) bv[bj][n] = *(const f32x4*)(bp + bj * 128 + 4 * n);
#pragma unroll
            for (int ai = 0; ai < 2; ++ai)
#pragma unroll
                for (int m = 0; m < 4; ++m) {
                    const float rsd = rsqrtf(pre.ssq[ai * 4 + m] * (1.0f / DM) + 1e-6f);
#pragma unroll
                    for (int bj = 0; bj < 2; ++bj)
#pragma unroll
                        for (int n = 0; n < 2; ++n) acc[ai][bj][m][n] = acc[ai][bj][m][n] * rsd + bv[bj][n];
                }
        }
        if (mode == EPI_GMLP1) {
            if (u.pn < 16) {
#pragma unroll
                for (int ai = 0; ai < 2; ++ai)
#pragma unroll
                    for (int m = 0; m < 4; ++m) {
                        const size_t row = (size_t)(row0 + ai * 128 + m * 16);
                        const f32x4 u0 = acc[ai][0][m][0], u1 = acc[ai][0][m][1], g0 = acc[ai][1][m][0], g1 = acc[ai][1][m][1];
                        u32x4 w;
                        { const f32x2 r = ugate2((f32x2){u0[0], u0[1]}, (f32x2){g0[0], g0[1]}); w.x = cvt_pk_bf16(r[0], r[1]); }
                        { const f32x2 r = ugate2((f32x2){u0[2], u0[3]}, (f32x2){g0[2], g0[3]}); w.y = cvt_pk_bf16(r[0], r[1]); }
                        { const f32x2 r = ugate2((f32x2){u1[0], u1[1]}, (f32x2){g1[0], g1[1]}); w.z = cvt_pk_bf16(r[0], r[1]); }
                        { const f32x2 r = ugate2((f32x2){u1[2], u1[3]}, (f32x2){g1[2], g1[3]}); w.w = cvt_pk_bf16(r[0], r[1]); }
                        *(u32x4*)(o0 + row * 2048 + u.pn * 128 + wc * 32 + fq * 8) = w;
                    }
            } else {
                const int g = u.pn - 16;
#pragma unroll
                for (int ai = 0; ai < 2; ++ai)
#pragma unroll
                    for (int m = 0; m < 4; ++m) {
                        const size_t row = (size_t)(row0 + ai * 128 + m * 16);
                        float s = 0.f, ss = 0.f;
#pragma unroll
                        for (int bj = 0; bj < 2; ++bj) {
                            float v[8];
#pragma unroll
                            for (int j = 0; j < 4; j += 2) { const f32x2 r0 = gelu2((f32x2){acc[ai][bj][m][0][j], acc[ai][bj][m][0][j + 1]}), r1 = gelu2((f32x2){acc[ai][bj][m][1][j], acc[ai][bj][m][1][j + 1]});
                                v[j] = r0[0]; v[j + 1] = r0[1]; v[4 + j] = r1[0]; v[5 + j] = r1[1]; }
#pragma unroll
                            for (int j = 0; j < 8; ++j) { s += v[j]; ss += v[j] * v[j]; }
                            u32x4 w; w.x = cvt_pk_bf16(v[0], v[1]); w.y = cvt_pk_bf16(v[2], v[3]); w.z = cvt_pk_bf16(v[4], v[5]); w.w = cvt_pk_bf16(v[6], v[7]);
                            *(u32x4*)(o1 + row * 2048 + g * 256 + bj * 128 + wc * 32 + fq * 8) = w;
                        }
                        { const int ln = fr + 16 * fq; s += shx(s, 16, ln); s += shx(s, 32, ln); ss += shx(ss, 16, ln); ss += shx(ss, 32, ln); }
                        if (fq == 0) *(f32x2*)(stats + (row * 32 + g * 4 + wc) * 2) = (f32x2){s, ss};
                    }
            }
        } else if (mode == EPI_POOL1) {
            const bool isg = u.pn >= 8; bf16_t* const o = isg ? o1 : o0; const int cb = (isg ? u.pn - 8 : u.pn) * 256 + wc * 32 + fq * 8;
#pragma unroll
            for (int ai = 0; ai < 2; ++ai)
#pragma unroll
                for (int m = 0; m < 4; ++m) {
                    const size_t row = (size_t)(row0 + ai * 128 + m * 16);
#pragma unroll
                    for (int bj = 0; bj < 2; ++bj) {
                        f32x4 v0 = acc[ai][bj][m][0], v1 = acc[ai][bj][m][1];
                        if (isg) {
#pragma unroll
                            for (int j = 0; j < 4; ++j) { v0[j] = silu_f(v0[j]); v1[j] = silu_f(v1[j]); }
                        }
                        u32x4 w; w.x = cvt_pk_bf16(v0[0], v0[1]); w.y = cvt_pk_bf16(v0[2], v0[3]); w.z = cvt_pk_bf16(v1[0], v1[1]); w.w = cvt_pk_bf16(v1[2], v1[3]);
                        *(u32x4*)(o + row * 2048 + cb + bj * 128) = w;
                    }
                }
        } else if (mode == EPI_ATTN1 || mode == EPI_ATTNC) {
            const bool ctx = (mode == EPI_ATTNC);
            const int sec = ctx ? (u.pn == 0 ? 1 : 2) : (u.pn < 4 ? 0 : (u.pn == 4 ? 1 : (u.pn == 5 ? 2 : 3)));
            if (sec <= 1) {
                const int j0 = 16 * (wc & 1) + 4 * fq;
                const float qs = (sec == 0) ? 0.125f : 1.0f;
#pragma unroll
                for (int ai = 0; ai < 2; ++ai) {
                    f32x4 cc[4], sn[4];
#pragma unroll
                    for (int m = 0; m < 4; ++m) {
                        cc[m] = (f32x4){1.f, 1.f, 1.f, 1.f}; sn[m] = (f32x4){0.f, 0.f, 0.f, 0.f};
                        if (!ctx) { const int s = (row0 + ai * 128 + m * 16) & (SEQ - 1); cc[m] = *(const f32x4*)(rc + s * 32 + j0); sn[m] = *(const f32x4*)(rs + s * 32 + j0); }
                    }
                    __builtin_amdgcn_sched_barrier(0);
#pragma unroll
                    for (int m = 0; m < 4; ++m) {
                        const int row = row0 + ai * 128 + m * 16;
                        const f32x4 c4 = cc[m] * qs, s4 = sn[m] * qs;
#pragma unroll
                        for (int bj = 0; bj < 2; ++bj) {
                            const f32x4 x1 = acc[ai][bj][m][0], x2 = acc[ai][bj][m][1];
                            const f32x4 a = x1 * c4 - x2 * s4, b = x2 * c4 + x1 * s4;
                            const int hl = 2 * bj + (wc >> 1);
                            bf16_t* p = (sec == 0) ? (o0 + (size_t)row * 1024 + (u.pn * 4 + hl) * 64 + j0) : ((ctx ? o0 : o1) + (size_t)row * 256 + hl * 64 + j0);
                            *(u32x2*)p = (u32x2){cvt_pk_bf16(a[0], a[1]), cvt_pk_bf16(a[2], a[3])};
                            *(u32x2*)(p + 32) = (u32x2){cvt_pk_bf16(b[0], b[1]), cvt_pk_bf16(b[2], b[3])};
                        }
                    }
                }
            } else if (sec == 2) {
                bf16_t* const vt = ctx ? o1 : o2; const int lsh = ctx ? 8 : 11, L = 1 << lsh;
#pragma unroll
                for (int ai = 0; ai < 2; ++ai)
#pragma unroll
                    for (int m = 0; m < 4; ++m) {
                        const int row = row0 + ai * 128 + m * 16, b = row >> lsh, t = row & (L - 1);
#pragma unroll
                        for (int bj = 0; bj < 2; ++bj) {
                            const int kvh = 2 * bj + (wc >> 1);
                            bf16_t* p = vt + ((size_t)((b * 4 + kvh) * 64 + 32 * (wc & 1) + 8 * fq) << lsh) + t;
#pragma unroll
                            for (int n = 0; n < 2; ++n)
#pragma unroll
                                for (int j = 0; j < 4; ++j) p[(size_t)(4 * n + j) << lsh] = (bf16_t)(cvt_pk_bf16(acc[ai][bj][m][n][j], 0.f) & 0xffffu);
                        }
                    }
            } else {
                const int cb = (u.pn - 6) * 256 + wc * 32 + fq * 8;
#pragma unroll
                for (int ai = 0; ai < 2; ++ai)
#pragma unroll
                    for (int m = 0; m < 4; ++m) {
                        const size_t row = (size_t)(row0 + ai * 128 + m * 16);
#pragma unroll
                        for (int bj = 0; bj < 2; ++bj) {
                            const f32x4 v0 = acc[ai][bj][m][0], v1 = acc[ai][bj][m][1];
                            u32x4 w; w.x = cvt_pk_bf16(silu_f(v0[0]), silu_f(v0[1])); w.y = cvt_pk_bf16(silu_f(v0[2]), silu_f(v0[3]));
                            w.z = cvt_pk_bf16(silu_f(v1[0]), silu_f(v1[1])); w.w = cvt_pk_bf16(silu_f(v1[2]), silu_f(v1[3]));
                            *(u32x4*)(o3 + row * 1024 + cb + bj * 128) = w;
                        }
                    }
            }
        } else if (mode == EPI_RES) {
            const bool lat = u.pm < ML / 256;
            const size_t tb = (lat ? (size_t)u.pm : (size_t)(u.pm - ML / 256)) * 256 * DM;
            const size_t tg = (size_t)u.pm * 256 * DM;
            const float* xi = (lat ? xil : xic) + tb; float* xo = xol + tb;
            const bf16_t* xbi = xb_in + tg; bf16_t* xbo = xb_out + tg;
            const int bb = lat ? (u.pm >> 3) : 32;
            const int colb = u.pn * 256 + wc * 32 + fq * 8;
            const float* gp = gate + bb * 3072 + colb;
            const unsigned lo = (unsigned)((wr * 64 + fr) * DM + colb) * 4u;
            f32x4 gv[2][2], gn[2][2];
#pragma unroll
            for (int bj = 0; bj < 2; ++bj)
#pragma unroll
                for (int n = 0; n < 2; ++n) {
                    gv[bj][n] = *(const f32x4*)(gp + bj * 128 + 4 * n);
                    if (hout) gn[bj][n] = *(const f32x4*)(gnext + colb + bj * 128 + 4 * n) * (*(const f32x4*)(modnext + bb * 3072 + 1024 + colb + bj * 128 + 4 * n) + 1.0f);
                }
            bf16_t* hb = hout + tg;
#define RES_BODY(AI, M, XV0, XV1, BJ) do { \
                        f32x4 t[2]; t[0] = (XV0) + gv[BJ][0] * acc[AI][BJ][M][0]; t[1] = (XV1) + gv[BJ][1] * acc[AI][BJ][M][1]; \
                        if (xmode == 2) { \
                            *(f32x4*)((char*)xo + lo + (unsigned)((((AI) * 128 + (M) * 16) * DM + (BJ) * 128) * 4)) = t[0]; \
                            *(f32x4*)((char*)xo + lo + (unsigned)((((AI) * 128 + (M) * 16) * DM + (BJ) * 128 + 4) * 4)) = t[1]; \
                        } else { \
                            *(u32x4*)((char*)xbo + (lo >> 1) + (unsigned)((((AI) * 128 + (M) * 16) * DM + (BJ) * 128) * 2)) = (u32x4){cvt_pk_bf16(t[0][0], t[0][1]), cvt_pk_bf16(t[0][2], t[0][3]), cvt_pk_bf16(t[1][0], t[1][1]), cvt_pk_bf16(t[1][2], t[1][3])}; \
                        } \
                        if (sumsq_out) ss += t[0][0] * t[0][0] + t[0][1] * t[0][1] + t[0][2] * t[0][2] + t[0][3] * t[0][3] + t[1][0] * t[1][0] + t[1][1] * t[1][1] + t[1][2] * t[1][2] + t[1][3] * t[1][3]; \
                        if (hout) { const f32x4 h0 = t[0] * gn[BJ][0], h1 = t[1] * gn[BJ][1]; \
                            *(u32x4*)((char*)hb + (lo >> 1) + (unsigned)((((AI) * 128 + (M) * 16) * DM + (BJ) * 128) * 2)) = (u32x4){cvt_pk_bf16(h0[0], h0[1]), cvt_pk_bf16(h0[2], h0[3]), cvt_pk_bf16(h1[0], h1[1]), cvt_pk_bf16(h1[2], h1[3])}; } \
                    } while (0)
#define RES_ROWSUM(AI, M) do { if (sumsq_out) { const int ln = fr + 16 * fq; ss += shx(ss, 16, ln); ss += shx(ss, 32, ln); \
                        if (fq == 0) (void)__hip_atomic_fetch_add(sumsq_out + row0 + (AI) * 128 + (M) * 16, ss, __ATOMIC_RELAXED, __HIP_MEMORY_SCOPE_AGENT); } } while (0)
            if (xmode == 0) {
#pragma unroll
                for (int am = 0; am < 4; ++am) {
                    const int ai = am >> 1, mb = (am & 1) * 2;
                    f32x4 xv[2][2][2];
#pragma unroll
                    for (int m2 = 0; m2 < 2; ++m2)
#pragma unroll
                        for (int bj = 0; bj < 2; ++bj)
#pragma unroll
                            for (int n = 0; n < 2; ++n) xv[m2][bj][n] = *(const f32x4*)((const char*)xi + lo + (unsigned)(((ai * 128 + (mb + m2) * 16) * DM + bj * 128 + 4 * n) * 4));
                    __builtin_amdgcn_sched_barrier(0);
#pragma unroll
                    for (int m2 = 0; m2 < 2; ++m2) {
                        float ss = 0.f;
#pragma unroll
                        for (int bj = 0; bj < 2; ++bj) RES_BODY(ai, mb + m2, xv[m2][bj][0], xv[m2][bj][1], bj);
                        RES_ROWSUM(ai, mb + m2);
                    }
                    __builtin_amdgcn_sched_barrier(0);
                }
            } else {
#pragma unroll
                for (int ai = 0; ai < 2; ++ai) {
                    u32x4 xw[4][2];
#pragma unroll
                    for (int m = 0; m < 4; ++m)
#pragma unroll
                        for (int bj = 0; bj < 2; ++bj) xw[m][bj] = *(const u32x4*)((const char*)xbi + (lo >> 1) + (unsigned)(((ai * 128 + m * 16) * DM + bj * 128) * 2));
                    __builtin_amdgcn_sched_barrier(0);
#pragma unroll
                    for (int m = 0; m < 4; ++m) {
                        float ss = 0.f;
#pragma unroll
                        for (int bj = 0; bj < 2; ++bj) {
                            const u32x4 w = xw[m][bj];
                            RES_BODY(ai, m, ((f32x4){bf_lo(w.x), bf_hi(w.x), bf_lo(w.y), bf_hi(w.y)}), ((f32x4){bf_lo(w.z), bf_hi(w.z), bf_lo(w.w), bf_hi(w.w)}), bj);
                        }
                        RES_ROWSUM(ai, m);
                    }
                    __builtin_amdgcn_sched_barrier(0);
                }
            }
#undef RES_BODY
#undef RES_ROWSUM
        } else if (mode == EPI_F32) {
            if (wr == 0) {
#pragma unroll
                for (int m = 0; m < 4; ++m)
#pragma unroll
                    for (int bj = 0; bj < 2; ++bj)
#pragma unroll
                        for (int n = 0; n < 2; ++n) *(f32x4*)((float*)o0 + (size_t)(m * 16 + fr) * ldc + u.pn * 256 + bj * 128 + wc * 32 + fq * 8 + 4 * n) = acc[0][bj][m][n];
            }
        } else {
            const int cb = u.pn * 256 + wc * 32 + fq * 8;
#pragma unroll
            for (int ai = 0; ai < 2; ++ai)
#pragma unroll
                for (int m = 0; m < 4; ++m) {
                    const size_t row = (size_t)(row0 + ai * 128 + m * 16);
#pragma unroll
                    for (int bj = 0; bj < 2; ++bj) {
                        const f32x4 v0 = acc[ai][bj][m][0], v1 = acc[ai][bj][m][1];
                        u32x4 w; w.x = cvt_pk_bf16(v0[0], v0[1]); w.y = cvt_pk_bf16(v0[2], v0[3]); w.z = cvt_pk_bf16(v1[0], v1[1]); w.w = cvt_pk_bf16(v1[2], v1[3]);
                        *(u32x4*)(o0 + row * ldc + cb + bj * 128) = w;
                    }
                }
        }
    }
};

struct Params {
    const float *x, *c, *ctx, *c_ctx, *ada_w, *ada_b, *norm_g, *final_g;
    const float *gmlp_w_in, *gmlp_vn_g, *gmlp_vn_b, *gmlp_w_s, *gmlp_b_s, *gmlp_w_out;
    const float *pool_w_in, *pool_w_grp, *pool_scale, *pool_w_out;
    const float *attn_w_in, *attn_sink, *attn_w_out;
    float* out; unsigned char* ws;
    int ph_lo, ph_hi;
};

__device__ __forceinline__ void prep_mod(int wv, LAS unsigned char* lds, const Params& P, int item) {
    const int tid = get_tid(wv), wave = tid >> 6, lane = tid & 63;
    const int layer = item / 48, nb = item % 48, col = nb * 64 + lane;
    LAS float* sc = (LAS float*)lds;
    LAS float* red = (LAS float*)(lds + 256 * 36 * 4);
    float acc[33];
#pragma unroll
    for (int b = 0; b < 33; ++b) acc[b] = 0.f;
    const float* W = P.ada_w + (size_t)layer * 1024 * 3072;
    for (int kc = 0; kc < 4; ++kc) {
        __syncthreads();
        for (int idx = tid; idx < 33 * 256; idx += 512) { const int b = idx >> 8, kk = idx & 255; const float v = (b < 32) ? P.c[b * 1024 + kc * 256 + kk] : P.c_ctx[kc * 256 + kk]; sc[kk * 36 + b] = v / (1.0f + __expf(-v)); }
        __syncthreads();
        for (int k2 = 0; k2 < 32; ++k2) {
            const int kk = wave * 32 + k2;
            const float wv = W[(size_t)(kc * 256 + kk) * 3072 + col];
#pragma unroll
            for (int b4 = 0; b4 < 8; ++b4) { const f32x4 s4 = *(const LAS f32x4*)(sc + kk * 36 + b4 * 4); acc[b4 * 4 + 0] += s4[0] * wv; acc[b4 * 4 + 1] += s4[1] * wv; acc[b4 * 4 + 2] += s4[2] * wv; acc[b4 * 4 + 3] += s4[3] * wv; }
            acc[32] += sc[kk * 36 + 32] * wv;
        }
    }
#pragma unroll
    for (int b = 0; b < 33; ++b) red[(wave * 33 + b) * 64 + lane] = acc[b];
    __syncthreads();
    for (int idx = tid; idx < 33 * 64; idx += 512) {
        const int b = idx >> 6, l = idx & 63; float s = 0.f;
#pragma unroll
        for (int w = 0; w < 8; ++w) s += red[(w * 33 + b) * 64 + l];
        const int cc = nb * 64 + l;
        ((float*)(P.ws + WS_MOD))[(size_t)layer * MODSZ + b * 3072 + cc] = s + P.ada_b[layer * 3072 + cc];
    }
    __syncthreads();
}

struct ConvTile { const float* src; bf16_t* dst; int ldn, K, L0, P0, k0, rope; };
__device__ __forceinline__ void conv_decode(const Params& P, int t, ConvTile& c) {
    unsigned char* ws = P.ws;
    c.rope = 0;
    if (t < 3072) {
        const int j = t / 1536, tt = t % 1536, kt = tt / 96, nt = tt % 96, p0 = nt * 64;
        c.src = P.gmlp_w_in + (size_t)j * 1024 * 6144; c.dst = (bf16_t*)(ws + (j ? WS_GIN1 : WS_GIN0)); c.ldn = 6144; c.K = 1024; c.k0 = kt * 64; c.P0 = p0;
        c.L0 = (p0 < 4096) ? (((p0 & 255) >= 128 ? 4096 : 0) + 128 * (p0 >> 8) + (p0 & 127)) : (2048 + (p0 - 4096));
        return;
    }
    t -= 3072;
    if (t < 1024) {
        const int j = t / 512, tt = t % 512, kt = tt / 16, nt = tt % 16;
        c.src = P.gmlp_w_out + (size_t)j * 2048 * 1024; c.dst = (bf16_t*)(ws + (j ? WS_GOUT1 : WS_GOUT0)); c.ldn = 1024; c.K = 2048; c.k0 = kt * 64; c.P0 = nt * 64; c.L0 = nt * 64; return;
    }
    t -= 1024;
    if (t < 512) {
        const int kt = t / 32, nt = t % 32;
        c.src = P.pool_w_in; c.dst = (bf16_t*)(ws + WS_PINT); c.ldn = 4096; c.K = 1024; c.k0 = kt * 64; c.P0 = 2048 + nt * 64; c.L0 = 2048 + nt * 64; return;
    }
    t -= 512;
    if (t < 256) {
        const int g = t / 64, tt = t % 64, kt = tt / 8, nt = tt % 8;
        c.src = P.pool_w_grp + (size_t)g * 512 * 512; c.dst = (bf16_t*)(ws + WS_PGRPT) + (size_t)g * 512 * 512; c.ldn = 512; c.K = 512; c.k0 = kt * 64; c.P0 = nt * 64; c.L0 = nt * 64; return;
    }
    t -= 256;
    if (t < 512) {
        const int kt = t / 16, nt = t % 16;
        c.src = P.pool_w_out; c.dst = (bf16_t*)(ws + WS_POUT); c.ldn = 1024; c.K = 2048; c.k0 = kt * 64; c.P0 = nt * 64; c.L0 = nt * 64; return;
    }
    t -= 512;
    if (t < 640) {
        const int kt = t / 40, nt = t % 40;
        c.src = P.attn_w_in; c.dst = (bf16_t*)(ws + WS_AIN); c.ldn = 2560; c.K = 1024; c.k0 = kt * 64; c.P0 = nt * 64; c.L0 = nt * 64; c.rope = (nt < 20); return;
    }
    t -= 640;
    {
        const int kt = t / 16, nt = t % 16;
        c.src = P.attn_w_out; c.dst = (bf16_t*)(ws + WS_AOUT); c.ldn = 1024; c.K = 1024; c.k0 = kt * 64; c.P0 = nt * 64; c.L0 = nt * 64; return;
    }
}
constexpr int N_CONV_TILES = 3072 + 1024 + 512 + 256 + 512 + 640 + 256;

__device__ __forceinline__ void prep_phase(int wv, LAS unsigned char* lds, const Params& P) {
    const int tid = get_tid(wv), G = gridDim.x, bid = blockIdx.x;
    for (int item = bid; item < 192; item += G) prep_mod(wv, lds, P, item);
    {
        float* rc = (float*)(P.ws + WS_ROPEC); float* rs = (float*)(P.ws + WS_ROPES);
        for (int i = bid * 512 + tid; i < 2048 * 32; i += G * 512) {
            const int s = i >> 5, j = i & 31; const float pos = (float)((j < 16) ? (s >> 6) : (s & 63));
            const float inv = exp2f(-(float)(j & 15) * (13.287712379549449f / 16.0f));
            const float ang = pos * inv, tr = ang * 0.15915494309189535f;
            rc[i] = __builtin_amdgcn_cosf(tr); rs[i] = __builtin_amdgcn_sinf(tr);
        }
        bf16_t* pn = (bf16_t*)(P.ws + WS_PINNT);
        for (int i = bid * 512 + tid; i < 1024 * 256; i += G * 512) {
            const int r = i >> 8, c8 = i & 255; const float* s = P.pool_w_in + (size_t)r * 4096 + c8 * 8;
            const f32x4 a = *(const f32x4*)s, b = *(const f32x4*)(s + 4);
            *(u32x4*)(pn + (size_t)r * 2048 + c8 * 8) = (u32x4){cvt_pk_bf16(a[0], a[1]), cvt_pk_bf16(a[2], a[3]), cvt_pk_bf16(b[0], b[1]), cvt_pk_bf16(b[2], b[3])};
        }
        { f32x4* sq = (f32x4*)(P.ws + WS_SUMSQ); for (int i = bid * 512 + tid; i < 3 * MT / 4; i += G * 512) sq[i] = (f32x4){0.f, 0.f, 0.f, 0.f}; }
        bf16_t* gw = (bf16_t*)(P.ws + WS_GWS);
        for (int i = bid * 512 + tid; i < 2 * 8 * 128 * 128 / 8; i += G * 512) {
            const float* s = P.gmlp_w_s + (size_t)i * 8; const f32x4 a = *(const f32x4*)s, b = *(const f32x4*)(s + 4);
            *(u32x4*)(gw + (size_t)i * 8) = (u32x4){cvt_pk_bf16(a[0], a[1]), cvt_pk_bf16(a[2], a[3]), cvt_pk_bf16(b[0], b[1]), cvt_pk_bf16(b[2], b[3])};
        }
    }
    LAS float* tb = (LAS float*)lds;
    const int kr = tid >> 4, nc4 = tid & 15;
    const int pr = tid >> 3, kq = tid & 7;
    for (int t0 = bid * 4; t0 < N_CONV_TILES; t0 += G * 4) {
        f32x4 v[4][2];
#pragma unroll
        for (int s = 0; s < 4; ++s) {
            ConvTile c; conv_decode(P, (t0 + s < N_CONV_TILES) ? t0 + s : t0, c);
#pragma unroll
            for (int j = 0; j < 2; ++j) v[s][j] = *(const f32x4*)(c.src + (size_t)(c.k0 + kr + 32 * j) * c.ldn + c.L0 + nc4 * 4);
        }
        __syncthreads();
#pragma unroll
        for (int s = 0; s < 4; ++s)
#pragma unroll
            for (int j = 0; j < 2; ++j)
#pragma unroll
                for (int e = 0; e < 4; ++e) tb[s * 4160 + (kr + 32 * j) * 65 + nc4 * 4 + e] = v[s][j][e];
        __syncthreads();
#pragma unroll
        for (int s = 0; s < 4; ++s) {
            if (t0 + s < N_CONV_TILES) {
                ConvTile c; conv_decode(P, t0 + s, c);
                const int lj = c.rope ? (4 * (pr >> 3) + (pr & 3) + 32 * ((pr >> 2) & 1)) : pr;
                float f[8];
#pragma unroll
                for (int e = 0; e < 8; ++e) f[e] = tb[s * 4160 + (kq * 8 + e) * 65 + lj];
                *(u32x4*)(c.dst + (size_t)(c.P0 + pr) * c.K + c.k0 + kq * 8) = (u32x4){cvt_pk_bf16(f[0], f[1]), cvt_pk_bf16(f[2], f[3]), cvt_pk_bf16(f[4], f[5]), cvt_pk_bf16(f[6], f[7])};
            }
        }
    }
    __syncthreads();
}

__device__ __forceinline__ void shift16_phase(int wv, const float* mod, bf16_t* S16) {
    const int tid = get_tid(wv);
    for (int i = blockIdx.x * 512 + tid; i < 3 * 256 * 128; i += gridDim.x * 512) {
        const int l = i >> 15, r = (i >> 7) & 255, c8 = i & 127;
        u32x4 w = (u32x4){0u, 0u, 0u, 0u};
        if (r < 33) { const float* s = mod + (size_t)(l + 1) * MODSZ + r * 3072 + c8 * 8; const f32x4 a = *(const f32x4*)s, b = *(const f32x4*)(s + 4);
            w = (u32x4){cvt_pk_bf16(a[0], a[1]), cvt_pk_bf16(a[2], a[3]), cvt_pk_bf16(b[0], b[1]), cvt_pk_bf16(b[2], b[3])}; }
        *(u32x4*)(S16 + (size_t)i * 8) = w;
    }
}

__device__ __forceinline__ void norm_phase(int wv, int vcu, bool rev, const float* xl, const float* xc, int nrows, const float* g, const float* modl, bf16_t* H) {
    const int tid_ = get_tid(wv); const int lane = tid_ & 63;
    f32x4 gv[4];
#pragma unroll
    for (int j = 0; j < 2; ++j) { gv[2 * j] = *(const f32x4*)(g + 512 * j + lane * 8); gv[2 * j + 1] = *(const f32x4*)(g + 512 * j + lane * 8 + 4); }
    constexpr int NR = 4;
    const int nun = nrows >> 5;
    for (int uu = vcu; uu < nun; uu += gridDim.x) {
        const int r0 = unit_remap(uu, nun, rev) * 32 + (tid_ >> 6) * 4; const int nw = 1;
        f32x4 v[NR][4];
#pragma unroll
        for (int q = 0; q < NR; ++q) {
            const int r = min(r0 + q * nw, nrows - 1);
            const float* xp = (r < ML) ? xl + (size_t)r * DM : xc + (size_t)(r - ML) * DM;
#pragma unroll
            for (int j = 0; j < 2; ++j) { v[q][2 * j] = *(const f32x4*)(xp + 512 * j + lane * 8); v[q][2 * j + 1] = *(const f32x4*)(xp + 512 * j + lane * 8 + 4); }
        }
#pragma unroll
        for (int q = 0; q < NR; ++q) {
            const int r = r0 + q * nw;
            if (r < nrows) {
                const float* mp = modl + ((r < ML) ? (r >> 11) : 32) * 3072;
                float ss = 0.f;
#pragma unroll
                for (int j = 0; j < 4; ++j) ss += v[q][j][0] * v[q][j][0] + v[q][j][1] * v[q][j][1] + v[q][j][2] * v[q][j][2] + v[q][j][3] * v[q][j][3];
                ss = wave_sum(ss, lane);
                const float rstd = rsqrtf(ss * (1.0f / DM) + 1e-6f);
#pragma unroll
                for (int j = 0; j < 2; ++j) {
                    const int k = 512 * j + lane * 8;
                    const f32x4 sh0 = *(const f32x4*)(mp + k), sh1 = *(const f32x4*)(mp + k + 4), sc0 = *(const f32x4*)(mp + 1024 + k), sc1 = *(const f32x4*)(mp + 1024 + k + 4);
                    const f32x4 a = v[q][2 * j] * rstd * gv[2 * j] * (sc0 + 1.0f) + sh0, b = v[q][2 * j + 1] * rstd * gv[2 * j + 1] * (sc1 + 1.0f) + sh1;
                    *(u32x4*)(H + (size_t)r * DM + k) = (u32x4){cvt_pk_bf16(a[0], a[1]), cvt_pk_bf16(a[2], a[3]), cvt_pk_bf16(b[0], b[1]), cvt_pk_bf16(b[2], b[3])};
                }
            }
        }
    }
}
__device__ __forceinline__ void final_phase(int wv, int vcu, bool rev, const bf16_t* x, float* out, const float* g) {
    const int tid_ = get_tid(wv); const int lane = tid_ & 63;
    f32x4 gv[4];
#pragma unroll
    for (int j = 0; j < 2; ++j) { gv[2 * j] = *(const f32x4*)(g + 512 * j + lane * 8); gv[2 * j + 1] = *(const f32x4*)(g + 512 * j + lane * 8 + 4); }
    constexpr int NR = 4;
    const int nun = ML >> 5;
    for (int uu = vcu; uu < nun; uu += gridDim.x) {
        const int r0 = unit_remap(uu, nun, rev) * 32 + (tid_ >> 6) * 4;
        u32x4 w[NR][2];
#pragma unroll
        for (int q = 0; q < NR; ++q) {
            const bf16_t* xp = x + (size_t)(r0 + q) * DM;
#pragma unroll
            for (int j = 0; j < 2; ++j) w[q][j] = *(const u32x4*)(xp + 512 * j + lane * 8);
        }
#pragma unroll
        for (int q = 0; q < NR; ++q) {
            float* xp = out + (size_t)(r0 + q) * DM;
            f32x4 v[4];
#pragma unroll
            for (int j = 0; j < 2; ++j) { const u32x4 ww = w[q][j]; v[2 * j] = (f32x4){bf_lo(ww.x), bf_hi(ww.x), bf_lo(ww.y), bf_hi(ww.y)}; v[2 * j + 1] = (f32x4){bf_lo(ww.z), bf_hi(ww.z), bf_lo(ww.w), bf_hi(ww.w)}; }
            float ss = 0.f;
#pragma unroll
            for (int j = 0; j < 4; ++j) ss += v[j][0] * v[j][0] + v[j][1] * v[j][1] + v[j][2] * v[j][2] + v[j][3] * v[j][3];
            ss = wave_sum(ss, lane);
            const float rstd = rsqrtf(ss * (1.0f / DM) + 1e-6f);
#pragma unroll
            for (int j = 0; j < 2; ++j) { *(f32x4*)(xp + 512 * j + lane * 8) = v[2 * j] * rstd * gv[2 * j]; *(f32x4*)(xp + 512 * j + lane * 8 + 4) = v[2 * j + 1] * rstd * gv[2 * j + 1]; }
        }
    }
}

__device__ __forceinline__ void spatial_phase(int wv, int vcu, bool rev, LAS unsigned char* lds, int nchunks, const bf16_t* UG, const bf16_t* GV, const float* stats, const bf16_t* WS16, const float* vn_g, const float* vn_b, const float* b_s, bf16_t* Y) {
    const int tid = get_tid(wv), wave = __builtin_amdgcn_readfirstlane(tid >> 6), lane = tid & 63, fr = lane & 15, fq = lane >> 4, wr = wave >> 2, wc = wave & 3;
    LAS f32x2* st = (LAS f32x2*)lds;
    LAS unsigned char* img = lds + 1024;
    LAS unsigned char* ugt = lds + 1024 + 65536;
    const int nunits = nchunks * 8;
    const int c8 = tid & 31, q0 = tid >> 5;
    u32x4 raw[8], ugr[8];
    if (vcu < nunits) {
        const int u = unit_remap(vcu, nunits, rev); const int g = u & 7; const size_t row0 = (size_t)(u >> 3) * 128;
#pragma unroll
        for (int it = 0; it < 8; ++it) { raw[it] = *(const u32x4*)(GV + (row0 + q0 + 16 * it) * 2048 + g * 256 + c8 * 8); ugr[it] = *(const u32x4*)(UG + (row0 + q0 + 16 * it) * 2048 + g * 256 + c8 * 8); }
    }
    for (int uu = vcu; uu < nunits; uu += gridDim.x) {
        const int u = unit_remap(uu, nunits, rev);
        const int g = u & 7, ch = u >> 3; const size_t row0 = (size_t)ch * 128;
        bf16x8 wf[4][4];
        {
            const bf16_t* wp = WS16 + (size_t)g * 16384 + (size_t)(wr * 64 + fr) * 128 + fq * 8;
#pragma unroll
            for (int ks = 0; ks < 4; ++ks)
#pragma unroll
                for (int m = 0; m < 4; ++m) wf[ks][m] = *(const bf16x8*)(wp + m * 16 * 128 + ks * 32);
        }
        {
            const int r = tid >> 2, part = tid & 3; const f32x4* sp = (const f32x4*)(stats + ((row0 + r) * 32 + part * 8) * 2);
            float s = 0.f, ss = 0.f;
#pragma unroll
            for (int i = 0; i < 4; ++i) { const f32x4 v = sp[i]; s += v[0] + v[2]; ss += v[1] + v[3]; }
            s += shx(s, 1, lane); s += shx(s, 2, lane); ss += shx(ss, 1, lane); ss += shx(ss, 2, lane);
            const float mean = s * (1.0f / 2048.0f), var = ss * (1.0f / 2048.0f) - mean * mean;
            if (part == 0) st[r] = (f32x2){mean, rsqrtf(fmaxf(var, 0.f) + 1e-6f)};
        }
#pragma unroll
        for (int it = 0; it < 8; ++it) *(LAS u32x4*)(ugt + (q0 + 16 * it) * 528 + c8 * 16) = ugr[it];
        __syncthreads();
        {
            const int cg = g * 256 + c8 * 8;
            const f32x4 G0 = *(const f32x4*)(vn_g + cg), G1 = *(const f32x4*)(vn_g + cg + 4), B0 = *(const f32x4*)(vn_b + cg), B1 = *(const f32x4*)(vn_b + cg + 4);
#pragma unroll
            for (int it = 0; it < 8; ++it) {
                const int q = q0 + 16 * it; const f32x2 ms = st[q]; const float mu = ms[0], rs = ms[1];
                const u32x4 w = raw[it]; u32x4 o;
                o.x = cvt_pk_bf16((bf_lo(w.x) - mu) * rs * G0[0] + B0[0], (bf_hi(w.x) - mu) * rs * G0[1] + B0[1]);
                o.y = cvt_pk_bf16((bf_lo(w.y) - mu) * rs * G0[2] + B0[2], (bf_hi(w.y) - mu) * rs * G0[3] + B0[3]);
                o.z = cvt_pk_bf16((bf_lo(w.z) - mu) * rs * G1[0] + B1[0], (bf_hi(w.z) - mu) * rs * G1[1] + B1[1]);
                o.w = cvt_pk_bf16((bf_lo(w.w) - mu) * rs * G1[2] + B1[2], (bf_hi(w.w) - mu) * rs * G1[3] + B1[3]);
                const int sw = (q & 3) | (((q >> 3) & 1) << 2);
                *(LAS u32x4*)(img + q * 512 + (((2 * c8) ^ (4 * sw)) * 8)) = o;
            }
        }
        __syncthreads();
        if (uu + (int)gridDim.x < nunits) {
            const int un = unit_remap(uu + gridDim.x, nunits, rev); const int gn = un & 7; const size_t rown = (size_t)(un >> 3) * 128;
#pragma unroll
            for (int it = 0; it < 8; ++it) { raw[it] = *(const u32x4*)(GV + (rown + q0 + 16 * it) * 2048 + gn * 256 + c8 * 8); ugr[it] = *(const u32x4*)(UG + (rown + q0 + 16 * it) * 2048 + gn * 256 + c8 * 8); }
        }
        f32x4 acc[4][4];
#pragma unroll
        for (int m = 0; m < 4; ++m)
#pragma unroll
            for (int n = 0; n < 4; ++n) acc[m][n] = (f32x4){0.f, 0.f, 0.f, 0.f};
        const int sw = (fr >> 2) | ((fq & 1) << 2);
#pragma unroll
        for (int ks = 0; ks < 4; ++ks) {
            bf16x8 vf[4];
#pragma unroll
            for (int n = 0; n < 4; ++n) {
                const int R = ks * 32 + 8 * fq + (fr >> 2), chunk = wc * 16 + n * 4 + (fr & 3);
                LAS unsigned char* a = img + R * 512 + ((chunk ^ (4 * sw)) * 8);
                const s16x4 lo = __builtin_amdgcn_ds_read_tr16_b64_v4i16((LAS s16x4*)a), hi = __builtin_amdgcn_ds_read_tr16_b64_v4i16((LAS s16x4*)(a + 2048));
                vf[n] = (bf16x8){lo[0], lo[1], lo[2], lo[3], hi[0], hi[1], hi[2], hi[3]};
            }
#pragma unroll
            for (int m = 0; m < 4; ++m)
#pragma unroll
                for (int n = 0; n < 4; ++n) acc[m][n] = __builtin_amdgcn_mfma_f32_16x16x32_bf16(vf[n], wf[ks][m], acc[m][n], 0, 0, 0);
        }
#pragma unroll
        for (int m = 0; m < 4; ++m) {
            const int p = wr * 64 + m * 16 + fr; const float bs = b_s[g * 128 + p];
#pragma unroll
            for (int n = 0; n < 4; ++n) {
                LAS u32x2* tp = (LAS u32x2*)(ugt + p * 528 + (wc * 64 + n * 16 + 4 * fq) * 2);
                const u32x2 ug = *tp; const f32x4 s = acc[m][n] + bs;
                *tp = (u32x2){cvt_pk_bf16(bf_lo(ug.x) * s[0], bf_hi(ug.x) * s[1]), cvt_pk_bf16(bf_lo(ug.y) * s[2], bf_hi(ug.y) * s[3])};
            }
        }
        __syncthreads();
#pragma unroll
        for (int it = 0; it < 8; ++it) *(u32x4*)(Y + (row0 + q0 + 16 * it) * 2048 + g * 256 + c8 * 8) = *(const LAS u32x4*)(ugt + (q0 + 16 * it) * 528 + c8 * 16);
        __syncthreads();
    }
}

__device__ __forceinline__ void pool_phase(int wv, int vcu, bool rev, LAS unsigned char* lds, const bf16_t* Z, const bf16_t* SG, const float* scale, bf16_t* Y) {
    const int tid = get_tid(wv);
    const int nunits = (MT / 128) * 8;
    u32x4 zr[9];
#define POOL_GEOM(uidx) const int u_ = unit_remap((uidx), nunits, rev); const int cb = u_ & 7, row0 = (u_ >> 3) * 128; int seq0, L; \
        if (row0 < ML) { seq0 = row0 & ~(SEQ - 1); L = SEQ; } else { seq0 = ML + ((row0 - ML) & ~(LC - 1)); L = LC; } const int t0 = row0 - seq0;
#define POOL_LOADZ() _Pragma("unroll") for (int it = 0; it < 9; ++it) { const int idx = tid + 512 * it, rr = idx >> 5, c8_ = idx & 31, t = t0 - 8 + rr; \
            zr[it] = (u32x4){0u, 0u, 0u, 0u}; if (t >= 0 && t < L) zr[it] = *(const u32x4*)(Z + (size_t)(seq0 + t) * 2048 + cb * 256 + c8_ * 8); }
    if (vcu < nunits) { POOL_GEOM(vcu) POOL_LOADZ() }
    for (int uu = vcu; uu < nunits; uu += gridDim.x) {
        POOL_GEOM(uu)
        const int hw = 1 << (cb >> 1);
        const int c8 = tid & 31, strip = tid >> 5, cg = cb * 256 + c8 * 8, tt0 = strip * 8;
        u32x4 sgv[8];
#pragma unroll
        for (int i = 0; i < 8; ++i) sgv[i] = *(const u32x4*)(SG + (size_t)(row0 + tt0 + i) * 2048 + cg);
#pragma unroll
        for (int it = 0; it < 9; ++it) { const int idx = tid + 512 * it; *(LAS u32x4*)(lds + (idx >> 5) * 512 + (idx & 31) * 16) = zr[it]; }
        __syncthreads();
        if (uu + (int)gridDim.x < nunits) {
            const int cb0 = cb, row00 = row0, t00 = t0, L0 = L, seq00 = seq0; (void)cb0; (void)row00; (void)t00; (void)L0; (void)seq00;
            { POOL_GEOM(uu + gridDim.x) POOL_LOADZ() }
        }
        const f32x4 sc0 = *(const f32x4*)(scale + cg), sc1 = *(const f32x4*)(scale + cg + 4);
        float sum[8];
#pragma unroll
        for (int e = 0; e < 8; ++e) sum[e] = 0.f;
        for (int rr = tt0 + 8 - hw; rr < tt0 + 8 + hw; ++rr) {
            const u32x4 w = *(const LAS u32x4*)(lds + rr * 512 + c8 * 16);
            sum[0] += bf_lo(w.x); sum[1] += bf_hi(w.x); sum[2] += bf_lo(w.y); sum[3] += bf_hi(w.y); sum[4] += bf_lo(w.z); sum[5] += bf_hi(w.z); sum[6] += bf_lo(w.w); sum[7] += bf_hi(w.w);
        }
#pragma unroll
        for (int i = 0; i < 8; ++i) {
            const int tt = tt0 + i, t = t0 + tt;
            const int lo = max(t - hw, 0), hi = min(t + hw, L);
            const float inv = 1.0f / (float)(hi - lo);
            const u32x4 cw = *(const LAS u32x4*)(lds + (tt + 8) * 512 + c8 * 16);
            const u32x4 sw = sgv[i];
            float y[8];
            y[0] = (sum[0] * inv - bf_lo(cw.x)) * sc0[0] * bf_lo(sw.x); y[1] = (sum[1] * inv - bf_hi(cw.x)) * sc0[1] * bf_hi(sw.x);
            y[2] = (sum[2] * inv - bf_lo(cw.y)) * sc0[2] * bf_lo(sw.y); y[3] = (sum[3] * inv - bf_hi(cw.y)) * sc0[3] * bf_hi(sw.y);
            y[4] = (sum[4] * inv - bf_lo(cw.z)) * sc1[0] * bf_lo(sw.z); y[5] = (sum[5] * inv - bf_hi(cw.z)) * sc1[1] * bf_hi(sw.z);
            y[6] = (sum[6] * inv - bf_lo(cw.w)) * sc1[2] * bf_lo(sw.w); y[7] = (sum[7] * inv - bf_hi(cw.w)) * sc1[3] * bf_hi(sw.w);
            *(u32x4*)(Y + (size_t)(row0 + tt) * 2048 + cg) = (u32x4){cvt_pk_bf16(y[0], y[1]), cvt_pk_bf16(y[2], y[3]), cvt_pk_bf16(y[4], y[5]), cvt_pk_bf16(y[6], y[7])};
            if (i < 7) {
                const u32x4 a = *(const LAS u32x4*)(lds + (tt + 8 + hw) * 512 + c8 * 16), b = *(const LAS u32x4*)(lds + (tt + 8 - hw) * 512 + c8 * 16);
                sum[0] += bf_lo(a.x) - bf_lo(b.x); sum[1] += bf_hi(a.x) - bf_hi(b.x); sum[2] += bf_lo(a.y) - bf_lo(b.y); sum[3] += bf_hi(a.y) - bf_hi(b.y);
                sum[4] += bf_lo(a.z) - bf_lo(b.z); sum[5] += bf_hi(a.z) - bf_hi(b.z); sum[6] += bf_lo(a.w) - bf_lo(b.w); sum[7] += bf_hi(a.w) - bf_hi(b.w);
            }
        }
        __syncthreads();
    }
#undef POOL_GEOM
#undef POOL_LOADZ
}

constexpr int AT_KB = 128 * 144, AT_VB = 64 * 264, AT_BUF = AT_KB + AT_VB;
__device__ __forceinline__ void attn_phase(int wv, int vcu, bool rev, LAS unsigned char* lds, const bf16_t* Q, const bf16_t* Kl, const bf16_t* VT, const bf16_t* KC, const bf16_t* VCT, const bf16_t* SGA, const float* sink, bf16_t* Y) {
    const int tid = get_tid(wv), wave = __builtin_amdgcn_readfirstlane(tid >> 6), lane = tid & 63, l32 = lane & 31, h = lane >> 5;
    const int gq = wave >> 1, qhalf = wave & 1;
    const float NEG = -1.0e30f;
    for (int uu = vcu; uu < NB * 4 * 16; uu += gridDim.x) {
        const int u = unit_remap(uu, NB * 4 * 16, rev);
        const int kvh = u & 3, n = (u >> 2) & 15, b = u >> 6, start = n * 128, head = kvh * 4 + gq;
        const int qrow0 = b * SEQ + start + qhalf * 64;
        bf16x8 qf[2][4];
        unsigned lrow_off = (unsigned)(l32 * 1024 + h * 8) * 2u;
        asm volatile("" : "+v"(lrow_off));
#pragma unroll
        for (int nq = 0; nq < 2; ++nq) {
            const char* qb = (const char*)(Q + (size_t)(qrow0 + nq * 32) * 1024 + head * 64);
#pragma unroll
            for (int ks = 0; ks < 4; ++ks) qf[nq][ks] = *(const bf16x8*)(qb + lrow_off + ks * 32);
        }
        const int has0 = n > 0, has2 = n < 15, nsteps = 3 + has0 + has2;
        f32x16 O[2][2];
#pragma unroll
        for (int a = 0; a < 2; ++a)
#pragma unroll
            for (int c = 0; c < 2; ++c)
#pragma unroll
                for (int i = 0; i < 16; ++i) O[a][c][i] = 0.f;
        float m_run[2] = {NEG, NEG}, l_run[2] = {0.f, 0.f};
        u32x4 stg[2];
#define AT_PTRS(s) const int _s = (s); const bf16_t* kp; const bf16_t* vp; int vst; \
        if (_s < 2) { kp = KC + (size_t)(b * LC + _s * 128) * 256 + kvh * 64; vp = VCT + (size_t)((b * 4 + kvh) * 64) * LC + _s * 128; vst = LC; } \
        else { const int li = _s - 2 + (has0 ? 0 : 1); kp = Kl + (size_t)(b * SEQ + start - 128 + li * 128) * 256 + kvh * 64; vp = VT + (size_t)((b * 4 + kvh) * 64) * SEQ + (start - 128 + li * 128); vst = SEQ; }
#define AT_LOADK(s) do { AT_PTRS(s) (void)vp; (void)vst; \
        _Pragma("unroll") for (int it = 0; it < 2; ++it) { const int idx = tid + 512 * it; stg[it] = *(const u32x4*)((const char*)kp + (unsigned)((idx >> 3) * 512 + (idx & 7) * 16)); } } while (0)
#define AT_LOADV(s) do { AT_PTRS(s) (void)kp; \
        _Pragma("unroll") for (int it = 0; it < 2; ++it) { const int idx = tid + 512 * it; stg[it] = *(const u32x4*)((const char*)vp + (unsigned)((idx >> 4) * vst * 2 + (idx & 15) * 16)); } } while (0)
#define AT_STOREK(buf) do { LAS unsigned char* _kb = lds + (buf) * AT_BUF; \
        _Pragma("unroll") for (int it = 0; it < 2; ++it) { const int idx = tid + 512 * it; *(LAS u32x4*)(_kb + (idx >> 3) * 144 + (idx & 7) * 16) = stg[it]; } } while (0)
#define AT_STOREV(buf) do { LAS unsigned char* _vb = lds + (buf) * AT_BUF + AT_KB; \
        _Pragma("unroll") for (int it = 0; it < 2; ++it) { const int idx = tid + 512 * it; \
            *(LAS u32x2*)(_vb + (idx >> 4) * 264 + (idx & 15) * 16) = (u32x2){stg[it].x, stg[it].y}; \
            *(LAS u32x2*)(_vb + (idx >> 4) * 264 + (idx & 15) * 16 + 8) = (u32x2){stg[it].z, stg[it].w}; } } while (0)
        AT_LOADK(0); AT_STOREK(0); AT_LOADV(0); AT_STOREV(0);
        __syncthreads();
        for (int s = 0; s < nsteps; ++s) {
            const bool more = s + 1 < nsteps;
            if (more) AT_LOADK(s + 1);
            const int li = (s < 2) ? 1 : (s - 2 + (has0 ? 0 : 1));
            LAS unsigned char* kb = lds + (s & 1) * AT_BUF; LAS unsigned char* vb = kb + AT_KB;
            const bool dead01 = (li == 0 && qhalf == 1), dead23 = (li == 2 && qhalf == 0);
#define AT_DEAD(it) (((it) >> 2) ? dead23 : dead01)
#define AT_ISSUE(it, SD) do { if (!AT_DEAD(it)) { const int blk_ = (it) >> 1, nq_ = (it) & 1; \
                _Pragma("unroll") for (int i = 0; i < 16; ++i) SD[i] = 0.f; \
                _Pragma("unroll") for (int ks = 0; ks < 4; ++ks) { \
                    const bf16x8 kf = *(const LAS bf16x8*)(kb + (blk_ * 32 + l32) * 144 + (ks * 16 + h * 8) * 2); \
                    SD = __builtin_amdgcn_mfma_f32_32x32x16_bf16(kf, qf[nq_][ks], SD, 0, 0, 0); } } } while (0)
#define AT_ITEM(it, SD) do { if (!AT_DEAD(it)) { const int blk_ = (it) >> 1, nq_ = (it) & 1; \
                if (li != 1) { const int qi = qhalf * 64 + nq_ * 32 + l32; \
                    _Pragma("unroll") for (int i = 0; i < 16; ++i) { const int kk = blk_ * 32 + 8 * (i >> 2) + 4 * h + (i & 3); const bool keep = (li == 0) ? (kk >= qi) : (kk <= qi); if (!keep) SD[i] = NEG; } } \
                float mx = NEG; \
                _Pragma("unroll") for (int i = 0; i < 16; i += 2) mx = fmaxf(fmaxf(mx, SD[i]), SD[i + 1]); \
                mx = fmaxf(mx, shx(mx, 32, lane)); \
                if (__builtin_amdgcn_ballot_w64(mx > m_run[nq_] + 8.0f) != 0ull) { \
                    const float mnew = fmaxf(m_run[nq_], mx), alpha = fexp2((m_run[nq_] - mnew) * L2E); \
                    m_run[nq_] = mnew; l_run[nq_] *= alpha; \
                    _Pragma("unroll") for (int i = 0; i < 16; ++i) { O[0][nq_][i] *= alpha; O[1][nq_][i] *= alpha; } } \
                const f32x2 ms2 = (f32x2){m_run[nq_] * L2E, m_run[nq_] * L2E}; f32x2 ls2 = (f32x2){0.f, 0.f}; unsigned pw[8]; \
                _Pragma("unroll") for (int i = 0; i < 16; i += 2) { \
                    const f32x2 t2 = (f32x2){SD[i], SD[i + 1]} * L2E - ms2; const f32x2 p2 = (f32x2){fexp2(t2[0]), fexp2(t2[1])}; \
                    ls2 += p2; pw[i >> 1] = cvt_pk_bf16(p2[0], p2[1]); } \
                l_run[nq_] += ls2[0] + ls2[1]; \
                _Pragma("unroll") for (int sl = 0; sl < 2; ++sl) { \
                    const bf16x8 pf = __builtin_bit_cast(bf16x8, ((u32x4){pw[4 * sl], pw[4 * sl + 1], pw[4 * sl + 2], pw[4 * sl + 3]})); \
                    const int kbase = blk_ * 32 + sl * 16 + 4 * h; \
                    _Pragma("unroll") for (int dm = 0; dm < 2; ++dm) { \
                        LAS unsigned char* vp = vb + (dm * 32 + l32) * 264 + kbase * 2; \
                        const u32x2 v0 = *(const LAS u32x2*)vp, v1 = *(const LAS u32x2*)(vp + 16); \
                        const bf16x8 vf = __builtin_bit_cast(bf16x8, ((u32x4){v0.x, v0.y, v1.x, v1.y})); \
                        O[dm][nq_] = __builtin_amdgcn_mfma_f32_32x32x16_bf16(vf, pf, O[dm][nq_], 0, 0, 0); } } } } while (0)
            {
                f32x16 SA, SB;
                AT_ISSUE(0, SA);
                AT_ISSUE(1, SB); AT_ITEM(0, SA);
                AT_ISSUE(2, SA); AT_ITEM(1, SB);
                AT_ISSUE(3, SB); AT_ITEM(2, SA);
                AT_ISSUE(4, SA); AT_ITEM(3, SB);
                if (more) { AT_STOREK((s + 1) & 1); AT_LOADV(s + 1); }
                AT_ISSUE(5, SB); AT_ITEM(4, SA);
                AT_ISSUE(6, SA); AT_ITEM(5, SB);
                AT_ISSUE(7, SB); AT_ITEM(6, SA);
                AT_ITEM(7, SB);
                if (more) { AT_STOREV((s + 1) & 1); }
            }
#undef AT_DEAD
#undef AT_ISSUE
#undef AT_ITEM
            __syncthreads();
        }
#undef AT_PTRS
#undef AT_LOADK
#undef AT_LOADV
#undef AT_STOREK
#undef AT_STOREV
        const float sk = sink[head];
#pragma unroll
        for (int nq = 0; nq < 2; ++nq) {
            const float lt = l_run[nq] + shx(l_run[nq], 32, lane) + fexp2((sk - m_run[nq]) * L2E);
            const float inv = 1.0f / lt;
            const size_t rob = ((size_t)(qrow0 + nq * 32) * 1024 + head * 64) * 2;
            unsigned lo = (unsigned)(l32 * 1024 + 4 * h) * 2u; asm volatile("" : "+v"(lo));
#pragma unroll
            for (int dm = 0; dm < 2; ++dm)
#pragma unroll
                for (int i4 = 0; i4 < 4; ++i4) {
                    const int d = dm * 32 + 8 * i4;
                    const u32x2 g = *(const u32x2*)((const char*)SGA + rob + lo + d * 2);
                    const float o0 = O[dm][nq][4 * i4 + 0] * inv * bf_lo(g.x), o1 = O[dm][nq][4 * i4 + 1] * inv * bf_hi(g.x), o2 = O[dm][nq][4 * i4 + 2] * inv * bf_lo(g.y), o3 = O[dm][nq][4 * i4 + 3] * inv * bf_hi(g.y);
                    *(u32x2*)((char*)Y + rob + lo + d * 2) = (u32x2){cvt_pk_bf16(o0, o1), cvt_pk_bf16(o2, o3)};
                }
        }
    }
}


#define XB_TMO      128
#define XB_XCNT(j)  (256  + 64 * (j))
#define XB_XSUB(j)  (1280 + 64 * (j))
#define XB_XGEN(j)  (2304 + 64 * (j))
#define XB_TOP      3328
#define XB_TOPGEN   3392
#define XCD_BAR_WORDS 3456
#define XB_SPIN_CAP (1u << 20)
__device__ __forceinline__ unsigned xb_ld(unsigned* p)              { return __hip_atomic_load(p, __ATOMIC_RELAXED, __HIP_MEMORY_SCOPE_AGENT); }
__device__ __forceinline__ unsigned xb_add(unsigned* p, unsigned v) { return __hip_atomic_fetch_add(p, v, __ATOMIC_RELAXED, __HIP_MEMORY_SCOPE_AGENT); }
__device__ __forceinline__ unsigned xb_xcc_id() { return (unsigned)__builtin_amdgcn_s_getreg((3 << 11) | 20) & 0xFu; }
#define XB_SPIN(cond, bar) do { unsigned _sp = 0; while (cond) { __builtin_amdgcn_s_sleep(1); \
    if ((++_sp & 255u) == 0u) { if (xb_ld(&(bar)[XB_TMO])) break; if (_sp > XB_SPIN_CAP) { atomicAdd(&(bar)[XB_TMO], 1u); break; } } } } while (0)
struct XcdBarrier { unsigned* bar; unsigned x; volatile LAS unsigned* st; };
__device__ __forceinline__ void xcd_barrier_complete(unsigned* bar, unsigned x, unsigned& nloc, unsigned& nx) {
    const unsigned G = gridDim.x;
    unsigned sum, cnt, mine, sp = 0u;
    for (;;) {
        sum = 0u; cnt = 0u; mine = 0u;
#pragma unroll
        for (unsigned j = 0; j < 16; ++j) { const unsigned c = xb_ld(&bar[XB_XCNT(j)]); sum += c; cnt += (c > 0u) ? 1u : 0u; mine = (j == x) ? c : mine; }
        if (sum == G) break;
        __builtin_amdgcn_s_sleep(1);
        if ((++sp & 255u) == 0u) { if (xb_ld(&bar[XB_TMO])) break; if (sp > XB_SPIN_CAP) { atomicAdd(&bar[XB_TMO], 1u); break; } }
    }
    nloc = mine > 0u ? mine : 1u; nx = cnt > 0u ? cnt : 1u;
}
__device__ __forceinline__ void xcd_barrier(const XcdBarrier& b, int tid) {
    asm volatile("s_waitcnt vmcnt(0)" ::: "memory");
    __syncthreads();
    if (tid == 0) {
        unsigned* bar = b.bar;
        __builtin_amdgcn_s_waitcnt(0);
        unsigned nloc = b.st[0], nx = b.st[1];
        if (nloc == 0u) { xcd_barrier_complete(bar, b.x, nloc, nx); b.st[0] = nloc; b.st[1] = nx; }
        const unsigned old = xb_add(&bar[XB_XSUB(b.x)], 1u);
        const unsigned gen = old / nloc;
        if (old + 1u == (gen + 1u) * nloc) {
            __builtin_amdgcn_fence(__ATOMIC_RELEASE, "agent");
            asm volatile("s_waitcnt vmcnt(0)" ::: "memory");
            const unsigned og = xb_add(&bar[XB_TOP], 1u);
            const unsigned tg = og / nx;
            if (og + 1u == (tg + 1u) * nx) xb_add(&bar[XB_TOPGEN], 1u);
            else XB_SPIN(xb_ld(&bar[XB_TOPGEN]) == tg, bar);
            __builtin_amdgcn_fence(__ATOMIC_ACQUIRE, "agent");
            xb_add(&bar[XB_XGEN(b.x)], 1u);
            asm volatile("s_waitcnt vmcnt(0)" ::: "memory");
        } else {
            XB_SPIN(xb_ld(&bar[XB_XGEN(b.x)]) == gen, bar);
            __builtin_amdgcn_fence(__ATOMIC_ACQUIRE, "agent");
            asm volatile("s_waitcnt vmcnt(0)" ::: "memory");
        }
    }
    __syncthreads();
}

constexpr int N_PHASES = 20;
__global__ void __launch_bounds__(512, 2) mega_fwd(Params P) {
    extern __shared__ __attribute__((aligned(16))) unsigned char lds_raw[];
    LAS unsigned char* lds = (LAS unsigned char*)lds_raw;
    cg::grid_group grid = cg::this_grid();
    unsigned char* const ws = P.ws;
    const int G = gridDim.x, bid = blockIdx.x;
    const int wv = __builtin_amdgcn_readfirstlane((int)threadIdx.x >> 6);
    XcdBarrier xb; xb.bar = (unsigned*)(ws + WS_CTL); xb.x = xb_xcc_id(); xb.st = (volatile LAS unsigned*)(lds + LDS_BYTES - 64);
    { const int t0 = get_tid(wv); if (t0 == 0) { xb.st[0] = 0u; xb.st[1] = 0u; xb.st[2] = xb_add(&xb.bar[XB_XCNT(xb.x)], 1u); xb.st[3] = (unsigned)bid; } __syncthreads(); }
#define IN(k) (P.ph_lo <= (k) && (k) < P.ph_hi)
#ifndef DUPMASK
#define DUPMASK 0
#endif
#define REP(k) for (int rep_ = 0; rep_ < (((DUPMASK) >> (k)) & 1) + 1; ++rep_)
#define SYNC(k) do { xcd_barrier(xb, get_tid(wv)); } while (0)
#define SYNC_CG(k) do { grid.sync(); } while (0)
#define WSP(T, off) ((T*)(ws + (off)))
#define MOD(layer) (WSP(float, WS_MOD) + (layer) * MODSZ)
#define AQ   (WSP(bf16_t, WS_R1))
#define ASG  (WSP(bf16_t, WS_R1) + (size_t)ML * 1024)
#define AK   (WSP(bf16_t, WS_R2))
#define AVT  (WSP(bf16_t, WS_R2) + (size_t)ML * 256)
#define AKC  (WSP(bf16_t, WS_R2) + (size_t)ML * 512)
#define AVCT (WSP(bf16_t, WS_R2) + (size_t)ML * 512 + (size_t)MC * 256)
#define RUN_GEMM(MODE, gm, E, oc, rv) do { pg8::StaticOrder S_; S_.init((gm).M, (gm).N, G, (oc), (rv)); pg8::gemm_phase<Epi<MODE>>(wv, lds, (gm), S_, (E)); } while (0)

    REP(0) if (IN(0)) prep_phase(wv, lds, P);
    SYNC_CG(0);
    int vcu = bid;
    {
        const int t0 = get_tid(wv);
        if (t0 == 0) {
            unsigned nx = 0u, ok = 1u;
#pragma unroll
            for (unsigned j = 0; j < 16; ++j) { const unsigned c = xb_ld(&xb.bar[XB_XCNT(j)]); if (j < 8u) { if (c * 8u != (unsigned)G) ok = 0u; nx += (c > 0u); } else if (c != 0u) ok = 0u; }
            if (ok && nx == 8u && xb.x < 8u && xb.st[2] * 8u < (unsigned)G) xb.st[3] = xb.st[2] * 8u + xb.x;
        }
        __syncthreads();
        vcu = __builtin_amdgcn_readfirstlane((int)xb.st[3]);
    }
#define XSB ((bf16_t*)P.out)
#define R0B WSP(bf16_t, WS_R0)
#define R1B WSP(bf16_t, WS_R1)
#define R2B WSP(bf16_t, WS_R2)
#define SUMSQ(i) (WSP(float, WS_SUMSQ) + (size_t)(i) * MT)
#define BIAS1 (WSP(float, WS_BIAS))
#define BIAS2 (WSP(float, WS_BIAS) + 64 * 4096)
#define BIAS3 (WSP(float, WS_BIAS) + 64 * (4096 + 2560))
    REP(1) if (IN(1)) { shift16_phase(wv, WSP(const float, WS_MOD), WSP(bf16_t, WS_SHIFT16)); norm_phase(wv, vcu, false, P.x, P.ctx, MT, P.norm_g, MOD(0), R0B); }
    REP(2) if (IN(2)) {
        pg8::Gemm gm{WSP(const bf16_t, WS_PGRPT), WSP(const bf16_t, WS_PINNT), 2048, 1024, 512, 512, 2048, 1, 1024u};
        Epi<EPI_BF16> E{}; E.o0 = WSP(bf16_t, WS_PINT); E.ldc = 1024; RUN_GEMM(EPI_BF16, gm, E, vcu, 0);
    }
    SYNC(2);
    REP(3) if (IN(3)) {
        pg8::Gemm gm{R0B, WSP(const bf16_t, WS_GIN0), MT, 6144, 1024, 1024, 1024, 0, 0u};
        Epi<EPI_GMLP1> E{}; E.o0 = R1B; E.o1 = R2B; E.stats = WSP(float, WS_STATS); RUN_GEMM(EPI_GMLP1, gm, E, vcu, 1);
    }
    SYNC(3);
    REP(4) if (IN(4)) spatial_phase(wv, vcu, false, lds, MT / 128, R1B, R2B, WSP(const float, WS_STATS), WSP(const bf16_t, WS_GWS), P.gmlp_vn_g, P.gmlp_vn_b, P.gmlp_b_s, R0B);
    SYNC(4);
    if (IN(5)) {
        pg8::Gemm gm{R0B, WSP(const bf16_t, WS_GOUT0), MT, 1024, 2048, 2048, 2048, 0, 0u};
        Epi<EPI_RES> E{}; E.gate = MOD(0) + 2048; E.xil = P.x; E.xic = P.ctx; E.xmode = 0; E.xb_in = XSB; E.xb_out = XSB;
        E.hout = R1B; E.sumsq_out = SUMSQ(0); E.gnext = P.norm_g + DM; E.modnext = MOD(1); RUN_GEMM(EPI_RES, gm, E, vcu, 1);
        for (int l = 0; l < 3; ++l) {
            const bf16_t* bt = l == 0 ? WSP(const bf16_t, WS_PINT) : (l == 1 ? WSP(const bf16_t, WS_AIN) : WSP(const bf16_t, WS_GIN1));
            const int nn = l == 0 ? 4096 : (l == 1 ? 2560 : 6144);
            pg8::Gemm gb{WSP(const bf16_t, WS_SHIFT16) + (size_t)l * 256 * 1024, bt, 256, nn, 1024, 1024, 1024, 0, 0u};
            Epi<EPI_F32> Eb{}; Eb.o0 = (bf16_t*)(l == 0 ? BIAS1 : (l == 1 ? BIAS2 : BIAS3)); Eb.ldc = nn; RUN_GEMM(EPI_F32, gb, Eb, (vcu + (l == 0 ? 128 : (l == 1 ? 112 : 102))) % G, 0);
        }
    }
    SYNC(5);
    REP(7) if (IN(7)) {
        pg8::Gemm gm{R1B, WSP(const bf16_t, WS_PINT), MT, 4096, 1024, 1024, 1024, 0, 0u};
        Epi<EPI_POOL1> E{}; E.o0 = R0B; E.o1 = R2B; E.sumsq_in = SUMSQ(0); E.bias = BIAS1; E.ldc = 4096; RUN_GEMM(EPI_POOL1, gm, E, vcu, 1);
    }
    SYNC(7);
    REP(8) if (IN(8)) pool_phase(wv, vcu, false, lds, R0B, R2B, P.pool_scale, R1B);
    SYNC(8);
    if (IN(9)) {
        pg8::Gemm gm{R1B, WSP(const bf16_t, WS_POUT), MT, 1024, 2048, 2048, 2048, 0, 0u};
        Epi<EPI_RES> E{}; E.gate = MOD(1) + 2048; E.xmode = 1; E.xb_in = XSB; E.xb_out = XSB;
        E.hout = R0B; E.sumsq_out = SUMSQ(1); E.gnext = P.norm_g + 2 * DM; E.modnext = MOD(2); RUN_GEMM(EPI_RES, gm, E, vcu, 1);
    }
    SYNC(9);
    REP(11) if (IN(11)) {
        pg8::Gemm gm{R0B, WSP(const bf16_t, WS_AIN), ML, 2560, 1024, 1024, 1024, 0, 0u};
        Epi<EPI_ATTN1> E{}; E.o0 = AQ; E.o1 = AK; E.o2 = AVT; E.o3 = ASG; E.rc = WSP(const float, WS_ROPEC); E.rs = WSP(const float, WS_ROPES);
        E.sumsq_in = SUMSQ(1); E.bias = BIAS2; E.ldc = 2560; RUN_GEMM(EPI_ATTN1, gm, E, vcu, 1);
    }
    REP(12) if (IN(12)) {
        pg8::Gemm gm{R0B + (size_t)ML * 1024, WSP(const bf16_t, WS_AIN) + (size_t)1024 * 1024, MC, 512, 1024, 1024, 1024, 0, 0u};
        Epi<EPI_ATTNC> E{}; E.o0 = AKC; E.o1 = AVCT; E.sumsq_in = SUMSQ(1); E.bias = BIAS2 + 1024; E.ldc = 2560; E.rowoff = ML; E.ctxonly = 1; RUN_GEMM(EPI_ATTNC, gm, E, (vcu + G / 2) % G, 0);
    }
    SYNC(12);
    REP(13) if (IN(13)) attn_phase(wv, vcu, false, lds, AQ, AK, AVT, AKC, AVCT, ASG, P.attn_sink, R0B);
    SYNC(13);
    if (IN(14)) {
        pg8::Gemm gm{R0B, WSP(const bf16_t, WS_AOUT), ML, 1024, 1024, 1024, 1024, 0, 0u};
        Epi<EPI_RES> E{}; E.gate = MOD(2) + 2048; E.xmode = 1; E.xb_in = XSB; E.xb_out = XSB;
        E.hout = R1B; E.sumsq_out = SUMSQ(2); E.gnext = P.norm_g + 3 * DM; E.modnext = MOD(3); RUN_GEMM(EPI_RES, gm, E, vcu, 1);
    }
    SYNC(14);
    REP(16) if (IN(16)) {
        pg8::Gemm gm{R1B, WSP(const bf16_t, WS_GIN1), ML, 6144, 1024, 1024, 1024, 0, 0u};
        Epi<EPI_GMLP1> E{}; E.o0 = R0B; E.o1 = R2B; E.stats = WSP(float, WS_STATS); E.sumsq_in = SUMSQ(2); E.bias = BIAS3; E.ldc = 6144; RUN_GEMM(EPI_GMLP1, gm, E, vcu, 1);
    }
    SYNC(16);
    REP(17) if (IN(17)) spatial_phase(wv, vcu, false, lds, ML / 128, R0B, R2B, WSP(const float, WS_STATS), WSP(const bf16_t, WS_GWS) + (size_t)8 * 16384, P.gmlp_vn_g + 2048, P.gmlp_vn_b + 2048, P.gmlp_b_s + 1024, R1B);
    SYNC(17);
    if (IN(18)) {
        pg8::Gemm gm{R1B, WSP(const bf16_t, WS_GOUT1), ML, 1024, 2048, 2048, 2048, 0, 0u};
        Epi<EPI_RES> E{}; E.gate = MOD(3) + 2048; E.xmode = 1; E.xb_in = XSB; E.xb_out = R0B; RUN_GEMM(EPI_RES, gm, E, vcu, 1);
    }
    SYNC(18);
    REP(19) if (IN(19)) final_phase(wv, vcu, false, R0B, P.out, P.final_g);
}

extern "C" void kernel_launch(void* const* d_in, const int* in_sizes, int n_in, void* d_out, int out_size, void* d_ws, size_t ws_size, hipStream_t stream) {
    static int grid = 0;
    if (grid == 0) {
        if (ws_size < WS_END) { fprintf(stderr, "kernel_launch: workspace too small (%zu < %zu)\n", ws_size, (size_t)WS_END); grid = -1; return; }
        int dev = 0, cus = 0, per_cu = 0;
        hipGetDevice(&dev);
        hipDeviceGetAttribute(&cus, hipDeviceAttributeMultiprocessorCount, dev);
        if (hipFuncSetAttribute((const void*)mega_fwd, hipFuncAttributeMaxDynamicSharedMemorySize, LDS_BYTES) != hipSuccess) { fprintf(stderr, "kernel_launch: hipFuncSetAttribute failed\n"); grid = -1; return; }
        if (hipOccupancyMaxActiveBlocksPerMultiprocessor(&per_cu, (const void*)mega_fwd, 512, LDS_BYTES) != hipSuccess || per_cu < 1) { fprintf(stderr, "kernel_launch: occupancy query gave %d\n", per_cu); per_cu = 1; }
        (void)hipGetLastError();
        grid = cus * per_cu;
        fprintf(stderr, "kernel_launch: grid %d (cus %d x %d)\n", grid, cus, per_cu);
    }
    if (grid < 0) return;
    if (hipMemsetAsync((char*)d_ws + WS_CTL, 0, 16384, stream) != hipSuccess) { fprintf(stderr, "kernel_launch: memset failed\n"); return; }
    Params p{};
    p.x = (const float*)d_in[0]; p.c = (const float*)d_in[1]; p.ctx = (const float*)d_in[2]; p.c_ctx = (const float*)d_in[3];
    p.ada_w = (const float*)d_in[4]; p.ada_b = (const float*)d_in[5]; p.norm_g = (const float*)d_in[6]; p.final_g = (const float*)d_in[7];
    p.gmlp_w_in = (const float*)d_in[8]; p.gmlp_vn_g = (const float*)d_in[9]; p.gmlp_vn_b = (const float*)d_in[10]; p.gmlp_w_s = (const float*)d_in[11];
    p.gmlp_b_s = (const float*)d_in[12]; p.gmlp_w_out = (const float*)d_in[13];
    p.pool_w_in = (const float*)d_in[14]; p.pool_w_grp = (const float*)d_in[15]; p.pool_scale = (const float*)d_in[16]; p.pool_w_out = (const float*)d_in[17];
    p.attn_w_in = (const float*)d_in[18]; p.attn_sink = (const float*)d_in[19]; p.attn_w_out = (const float*)d_in[20];
    p.out = (float*)d_out; p.ws = (unsigned char*)d_ws; p.ph_lo = 0; p.ph_hi = N_PHASES;
    void* args[] = {&p};
    hipError_t e = hipLaunchCooperativeKernel((const void*)mega_fwd, dim3(grid), dim3(512), args, LDS_BYTES, stream);
    if (e != hipSuccess) fprintf(stderr, "kernel_launch: cooperative launch failed: %s (grid %d)\n", hipGetErrorString(e), grid);
}
```
